# Optimizing an MI355X kernel written in HIP

```python
import math
import jax, jax.numpy as jnp
from jax import lax
import numpy as np

D_MODEL = 1024
BATCH = 2
SEQ = 8192
DEPTH = 4

EPS = 1e-5
ATTN_HEADS = 8
ATTN_KV_HEADS = 2
HEAD_DIM = 64
WINDOW = 128
ATTN_BLOCK = 128
ATTN_WIDTH = ATTN_HEADS * HEAD_DIM
KV_WIDTH = ATTN_KV_HEADS * HEAD_DIM
POOL_WINDOWS = (2, 4, 8, 16)
POOL_GROUPS = 4
POOL_WIDTH = D_MODEL // 2
POOL_GROUP_DIM = POOL_WIDTH // POOL_GROUPS
AP_IN = ATTN_WIDTH + 2 * KV_WIDTH + POOL_WIDTH
AP_OUT = ATTN_WIDTH + POOL_WIDTH
SSD_INNER = 2 * D_MODEL
SSD_HEAD_DIM = 64
SSD_HEADS = SSD_INNER // SSD_HEAD_DIM
SSD_GROUPS = 4
SSD_STATE = 128
SSD_CONV = 4
SSD_CHUNK = 128
SSD_CONV_DIM = SSD_INNER + 2 * SSD_GROUPS * SSD_STATE
SSD_IN = 2 * SSD_INNER + 2 * SSD_GROUPS * SSD_STATE + SSD_HEADS
FFN_HIDDEN = -(-8 * D_MODEL // (3 * 256)) * 256
N_EVEN = (DEPTH + 1) // 2
N_ODD = DEPTH // 2

kernel_name = "hybrid_swa_sink_pool_ssd_trunk"


def rmsnorm(x, w):
    xf = x.astype(jnp.float32)
    y = xf * lax.rsqrt(jnp.mean(xf * xf, axis=-1, keepdims=True) + EPS) * w.astype(jnp.float32)
    return y.astype(x.dtype)


def sliding_window_attention(q, k, v, sinks):
    b, s = q.shape[0], q.shape[1]
    nb = s // ATTN_BLOCK
    g = ATTN_HEADS // ATTN_KV_HEADS
    qb = q.reshape(b, nb, ATTN_BLOCK, ATTN_KV_HEADS, g, HEAD_DIM)

    def band(t):
        tp = jnp.pad(t, ((0, 0), (ATTN_BLOCK, 0), (0, 0), (0, 0)))
        tp = tp.reshape(b, nb + 1, ATTN_BLOCK, ATTN_KV_HEADS, HEAD_DIM)
        return jnp.concatenate([tp[:, :-1], tp[:, 1:]], axis=2)

    kb, vb = band(k), band(v)
    scores = jnp.einsum('bnqhgd,bnkhd->bnhgqk', qb, kb).astype(jnp.float32) * (HEAD_DIM ** -0.5)
    n_idx = jnp.arange(nb)[:, None, None]
    qi = jnp.arange(ATTN_BLOCK)[None, :, None]
    kj = jnp.arange(2 * ATTN_BLOCK)[None, None, :]
    diff = qi + ATTN_BLOCK - kj
    k_pos = (n_idx - 1) * ATTN_BLOCK + kj
    mask = (diff >= 0) & (diff < WINDOW) & (k_pos >= 0)
    scores = jnp.where(mask[None, :, None, None], scores, -1e30)
    sink = sinks.astype(jnp.float32).reshape(ATTN_KV_HEADS, g)[None, None, :, :, None, None]
    sink = jnp.broadcast_to(sink, scores.shape[:-1] + (1,))
    probs = jax.nn.softmax(jnp.concatenate([scores, sink], axis=-1), axis=-1)[..., :-1]
    out = jnp.einsum('bnhgqk,bnkhd->bnqhgd', probs.astype(vb.dtype), vb)
    return out.reshape(b, s, ATTN_WIDTH)


def multiscale_pool(u, pool_w, pool_scale):
    b, s, _ = u.shape
    uf = u.astype(jnp.float32)
    count = jnp.arange(1, s + 1, dtype=jnp.float32)[:, None]
    outs = []
    for gi, w in enumerate(POOL_WINDOWS):
        ug = uf[..., gi * POOL_GROUP_DIM:(gi + 1) * POOL_GROUP_DIM]
        cs = jnp.cumsum(ug, axis=1)
        lower = jnp.pad(cs[:, :s - w], ((0, 0), (w, 0), (0, 0)))
        mean = (cs - lower) / jnp.minimum(count, float(w))
        outs.append(mean - ug)
    d = jnp.stack(outs, axis=2)
    y = jnp.einsum('bsgc,gcd->bsgd', d, pool_w.astype(jnp.float32)).reshape(b, s, POOL_WIDTH)
    return (y * pool_scale.astype(jnp.float32)).astype(u.dtype)


def attn_pool_mixer(u, w_in, sinks, pool_w, pool_scale, w_out):
    b, s, _ = u.shape
    proj = u @ w_in
    q = proj[..., :ATTN_WIDTH].reshape(b, s, ATTN_HEADS, HEAD_DIM)
    k = proj[..., ATTN_WIDTH:ATTN_WIDTH + KV_WIDTH].reshape(b, s, ATTN_KV_HEADS, HEAD_DIM)
    v = proj[..., ATTN_WIDTH + KV_WIDTH:ATTN_WIDTH + 2 * KV_WIDTH].reshape(b, s, ATTN_KV_HEADS, HEAD_DIM)
    p = proj[..., ATTN_WIDTH + 2 * KV_WIDTH:]
    a = sliding_window_attention(q, k, v, sinks)
    m = multiscale_pool(p, pool_w, pool_scale)
    return jnp.concatenate([a, m], axis=-1) @ w_out


def causal_depthwise_conv(x, w, bias):
    s = x.shape[1]
    xp = jnp.pad(x, ((0, 0), (SSD_CONV - 1, 0), (0, 0)))
    out = xp[:, 0:s] * w[0]
    for kk in range(1, SSD_CONV):
        out = out + xp[:, kk:kk + s] * w[kk]
    return out + bias


def ssd_chunked(x, dt, A, Bm, Cm):
    b, s, h, p = x.shape
    L = SSD_CHUNK
    nc = s // L
    G = SSD_GROUPS
    hg = h // G
    n = SSD_STATE
    xdt = (x.astype(jnp.float32) * dt[..., None]).reshape(b, nc, L, G, hg, p)
    Bc = Bm.astype(jnp.float32).reshape(b, nc, L, G, n)
    Cc = Cm.astype(jnp.float32).reshape(b, nc, L, G, n)
    dA = (dt * A).reshape(b, nc, L, G, hg)
    a_cs = jnp.moveaxis(jnp.cumsum(dA, axis=2), 2, -1)
    seg = a_cs[..., :, None] - a_cs[..., None, :]
    causal = jnp.tril(jnp.ones((L, L), dtype=bool))
    decay = jnp.exp(jnp.where(causal, seg, -jnp.inf))
    cb = jnp.einsum('bclgn,bcsgn->bcgls', Cc, Bc)
    y_diag = jnp.einsum('bcgls,bcghls,bcsghp->bclghp', cb, decay, xdt)
    decay_states = jnp.exp(a_cs[..., -1:] - a_cs)
    states = jnp.einsum('bclgn,bcghl,bclghp->bcghpn', Bc, decay_states, xdt)
    chunk_decay = jnp.exp(a_cs[..., -1])

    def step(hstate, inp):
        st, dec = inp
        return hstate * dec[..., None, None] + st, hstate

    h0 = jnp.zeros((b, G, hg, p, n), jnp.float32)
    _, prev = lax.scan(step, h0, (jnp.moveaxis(states, 1, 0), jnp.moveaxis(chunk_decay, 1, 0)))
    prev = jnp.moveaxis(prev, 0, 1)
    y_off = jnp.einsum('bclgn,bcghpn,bcghl->bclghp', Cc, prev, jnp.exp(a_cs))
    return (y_diag + y_off).reshape(b, s, h, p)


def ssd_mixer(u, w_in, conv_w, conv_b, dt_bias, A_log, D, norm_w, w_out):
    b, s, _ = u.shape
    proj = u @ w_in
    z = proj[..., :SSD_INNER]
    xbc = proj[..., SSD_INNER:SSD_INNER + SSD_CONV_DIM]
    dt_raw = proj[..., SSD_INNER + SSD_CONV_DIM:]
    xbc = jax.nn.silu(causal_depthwise_conv(xbc, conv_w, conv_b))
    gn = SSD_GROUPS * SSD_STATE
    xs = xbc[..., :SSD_INNER].reshape(b, s, SSD_HEADS, SSD_HEAD_DIM)
    Bm = xbc[..., SSD_INNER:SSD_INNER + gn].reshape(b, s, SSD_GROUPS, SSD_STATE)
    Cm = xbc[..., SSD_INNER + gn:].reshape(b, s, SSD_GROUPS, SSD_STATE)
    dt = jax.nn.softplus(dt_raw.astype(jnp.float32) + dt_bias.astype(jnp.float32))
    A = -jnp.exp(A_log.astype(jnp.float32))
    y = ssd_chunked(xs, dt, A, Bm, Cm) + xs.astype(jnp.float32) * D.astype(jnp.float32)[:, None]
    y = y.reshape(b, s, SSD_INNER) * jax.nn.silu(z.astype(jnp.float32))
    yg = y.reshape(b, s, SSD_GROUPS, SSD_INNER // SSD_GROUPS)
    yg = yg * lax.rsqrt(jnp.mean(yg * yg, axis=-1, keepdims=True) + EPS)
    y = yg.reshape(b, s, SSD_INNER) * norm_w.astype(jnp.float32)
    return y.astype(u.dtype) @ w_out


def swiglu(h, w_gate, w_up, w_down):
    return (jax.nn.silu(h @ w_gate) * (h @ w_up)) @ w_down


def setup_inputs(seed: int = 0) -> dict:
    key = jax.random.key(seed)
    ks = jax.random.split(key, 24)
    f32 = jnp.float32

    def nrm(k, shape, scale):
        return jax.random.normal(k, shape, f32) * scale

    x = jax.random.normal(ks[0], (BATCH, SEQ, D_MODEL), f32)
    mix_norm_w = 1.0 + nrm(ks[1], (DEPTH, D_MODEL), 0.1)
    ap_w_in = nrm(ks[2], (N_EVEN, D_MODEL, AP_IN), D_MODEL ** -0.5)
    ap_sinks = nrm(ks[3], (N_EVEN, ATTN_HEADS), 0.5)
    pool_w = nrm(ks[4], (N_EVEN, POOL_GROUPS, POOL_GROUP_DIM, POOL_GROUP_DIM), POOL_GROUP_DIM ** -0.5)
    pool_scale = 1.0 + nrm(ks[5], (N_EVEN, POOL_WIDTH), 0.1)
    ap_w_out = nrm(ks[6], (N_EVEN, AP_OUT, D_MODEL), AP_OUT ** -0.5)
    ssd_w_in = nrm(ks[7], (N_ODD, D_MODEL, SSD_IN), D_MODEL ** -0.5)
    ssd_conv_w = nrm(ks[8], (N_ODD, SSD_CONV, SSD_CONV_DIM), SSD_CONV ** -0.5)
    ssd_conv_b = nrm(ks[9], (N_ODD, SSD_CONV_DIM), 0.02)
    dt0 = jnp.exp(jax.random.uniform(ks[10], (N_ODD, SSD_HEADS), f32, math.log(1e-3), math.log(1e-1)))
    ssd_dt_bias = dt0 + jnp.log(-jnp.expm1(-dt0))
    ssd_A_log = jnp.log(jax.random.uniform(ks[11], (N_ODD, SSD_HEADS), f32, 1.0, 16.0))
    ssd_D = 1.0 + nrm(ks[12], (N_ODD, SSD_HEADS), 0.1)
    ssd_norm_w = 1.0 + nrm(ks[13], (N_ODD, SSD_INNER), 0.1)
    ssd_w_out = nrm(ks[14], (N_ODD, SSD_INNER, D_MODEL), SSD_INNER ** -0.5)
    ffn_norm_w = 1.0 + nrm(ks[15], (DEPTH, D_MODEL), 0.1)
    w_gate = nrm(ks[16], (DEPTH, D_MODEL, FFN_HIDDEN), D_MODEL ** -0.5)
    w_up = nrm(ks[17], (DEPTH, D_MODEL, FFN_HIDDEN), D_MODEL ** -0.5)
    w_down = nrm(ks[18], (DEPTH, FFN_HIDDEN, D_MODEL), FFN_HIDDEN ** -0.5)
    final_norm_w = 1.0 + nrm(ks[19], (D_MODEL,), 0.1)
    return {"x": x, "mix_norm_w": mix_norm_w, "ap_w_in": ap_w_in, "ap_sinks": ap_sinks,
            "pool_w": pool_w, "pool_scale": pool_scale, "ap_w_out": ap_w_out,
            "ssd_w_in": ssd_w_in, "ssd_conv_w": ssd_conv_w, "ssd_conv_b": ssd_conv_b,
            "ssd_dt_bias": ssd_dt_bias, "ssd_A_log": ssd_A_log, "ssd_D": ssd_D,
            "ssd_norm_w": ssd_norm_w, "ssd_w_out": ssd_w_out, "ffn_norm_w": ffn_norm_w,
            "w_gate": w_gate, "w_up": w_up, "w_down": w_down, "final_norm_w": final_norm_w}


def reference(x, mix_norm_w, ap_w_in, ap_sinks, pool_w, pool_scale, ap_w_out,
              ssd_w_in, ssd_conv_w, ssd_conv_b, ssd_dt_bias, ssd_A_log, ssd_D,
              ssd_norm_w, ssd_w_out, ffn_norm_w, w_gate, w_up, w_down, final_norm_w):
    for layer in range(DEPTH):
        i = layer // 2
        h = rmsnorm(x, mix_norm_w[layer])
        if layer % 2 == 0:
            x = x + attn_pool_mixer(h, ap_w_in[i], ap_sinks[i], pool_w[i], pool_scale[i], ap_w_out[i])
        else:
            x = x + ssd_mixer(h, ssd_w_in[i], ssd_conv_w[i], ssd_conv_b[i], ssd_dt_bias[i],
                              ssd_A_log[i], ssd_D[i], ssd_norm_w[i], ssd_w_out[i])
        h = rmsnorm(x, ffn_norm_w[layer])
        x = x + swiglu(h, w_gate[layer], w_up[layer], w_down[layer])
    return rmsnorm(x, final_norm_w)
```

```cpp
#include <hip/hip_runtime.h>
#include <hip/hip_cooperative_groups.h>
#include <cstdio>
namespace cg = cooperative_groups;

#ifndef COOP
#define COOP 1
#endif

typedef unsigned short bf16_t;
typedef short bf16x8 __attribute__((ext_vector_type(8)));
typedef short s16x4 __attribute__((ext_vector_type(4)));
typedef float f32x4 __attribute__((ext_vector_type(4)));
typedef float f32x16 __attribute__((ext_vector_type(16)));
typedef unsigned u32x4 __attribute__((ext_vector_type(4)));
typedef unsigned u32x2 __attribute__((ext_vector_type(2)));
typedef __bf16 bf2_t __attribute__((ext_vector_type(2)));
typedef float f32x2 __attribute__((ext_vector_type(2)));

#define DI __device__ __forceinline__
#define MFMA(a, b, c) __builtin_amdgcn_mfma_f32_32x32x16_bf16((a), (b), (c), 0, 0, 0)

constexpr int T = 16384;
constexpr int SEQ = 8192;
constexpr int NPH = 28;
constexpr size_t LDS_BYTES = 144016;

constexpr size_t W_IN = 0, W_OUT = 5505024, W_GU = 7602176, W_DN = 13369344, W_POOL = 16252928, W_TOTAL = 16318464;

struct Params {
  const float *x, *mix_norm_w, *ap_w_in, *ap_sinks, *pool_w, *pool_scale, *ap_w_out, *ssd_w_in, *ssd_conv_w, *ssd_conv_b,
      *ssd_dt_bias, *ssd_A_log, *ssd_D, *ssd_norm_w, *ssd_w_out, *ffn_norm_w, *w_gate, *w_up, *w_down, *final_norm_w;
  float* X;
  bf16_t *Wb, *H, *P, *CB, *S;
  float *dt, *acs, *ssq;
  unsigned* bar;
};

DI unsigned pk2(float lo, float hi) { f32x2 v = {lo, hi}; bf2_t r = __builtin_convertvector(v, bf2_t); return __builtin_bit_cast(unsigned, r); }
DI float bflo(unsigned u) { return __uint_as_float(u << 16); }
DI float bfhi(unsigned u) { return __uint_as_float(u & 0xffff0000u); }
DI float silu(float x) { return x * __builtin_amdgcn_rcpf(1.f + __expf(-x)); }
DI int crow(int i, int h) { return (i & 3) + 8 * (i >> 2) + 4 * h; }
DI int otid() { int t = threadIdx.x; asm volatile("" : "+v"(t)); return t; }
DI float wave_sum(float v) {
#pragma unroll
  for (int o = 32; o >= 1; o >>= 1) v += __shfl_xor(v, o);
  return v;
}
DI void unpack8(u32x4 r, float (&f)[8]) {
#pragma unroll
  for (int e = 0; e < 4; ++e) { f[2 * e] = bflo(r[e]); f[2 * e + 1] = bfhi(r[e]); }
}
DI u32x4 pack8(const float (&f)[8]) { u32x4 r; r[0] = pk2(f[0], f[1]); r[1] = pk2(f[2], f[3]); r[2] = pk2(f[4], f[5]); r[3] = pk2(f[6], f[7]); return r; }
DI int swz64(int r, int c) { return r * 128 + ((c ^ ((r >> 1) & 7)) << 4); }
DI int swz128(int r, int c) { return r * 256 + ((c ^ (r & 15)) << 4); }

namespace pg8 {
#define PG8_LAS __attribute__((address_space(3)))
constexpr int BM = 256, BK = 64, HALF = 128, HTB = HALF * BK * 2, NXCD = 8, WGM = 8;
DI float row_rstd(const float* ssq, int row) { const f32x4* q = (const f32x4*)(ssq + (size_t)row * 16); const f32x4 a = q[0] + q[1] + q[2] + q[3]; return rsqrtf((a[0] + a[1] + a[2] + a[3]) * (1.f / 1024.f) + 1e-5f); }
DI int lds_byte(int r, int c) { const int st = (r >> 4) * 2 + (c >> 5), rr = r & 15, cc = c & 31, ob = rr * 64 + cc * 2; return st * 1024 + (ob ^ (((ob >> 9) & 1) << 5)); }
DI void stage_rc(int b, int& R, int& C) { const int st = b / 1024, sb = b % 1024, swz = sb ^ (((sb >> 9) & 1) << 5); R = (st >> 1) * 16 + swz / 64; C = (st & 1) * 32 + (swz % 64) / 2; }
DI int perm32(int rho) { const int n = rho >> 4, i = rho & 15; return 8 * (i >> 2) + 4 * n + (i & 3); }
struct Unit { int pm, pn; };
struct Gemm { const bf16_t* A; const bf16_t* Bt; int lda, N, K; };
struct StaticOrder {
  int nM, nN, nwg, G, c;
  DI void init(int M, int N, int G_, int c_) { nM = M / BM; nN = N / BM; nwg = nM * nN; G = G_; c = c_; }
  DI bool next(int i, Unit& u) const {
    const long L = (long)i * G + c; if (L >= nwg) return false;
    int wgid = (int)L; { const int q = nwg / NXCD, r = nwg % NXCD, xcd = wgid % NXCD, off = wgid / NXCD; wgid = (xcd < r ? xcd * (q + 1) : r * (q + 1) + (xcd - r) * q) + off; }
    const int nig = WGM * nN, gid = wgid / nig, fm = gid * WGM, gsz = (nM - fm) < WGM ? (nM - fm) : WGM;
    u.pm = fm + ((wgid % nig) % gsz); u.pn = (wgid % nig) / gsz; return true;
  }
};
struct EpiBf16 {
  static constexpr bool PERM = true, RSTD = true;
  bf16_t* C; int ldc; float* dt; const float* bias; const float* ssq;
  DI void operator()(const f32x4 (&acc)[2][2][4][2], const Unit& u, int wr, int wc, int fr, int fq, const PG8_LAS float* sR) const {
    const int row0 = u.pm * BM + wr * 64 + fr;
    if (dt != nullptr && u.pn == 20) {
      if (wc == 0) {
        const f32x4 b0 = *(const f32x4*)(bias + 8 * fq), b1 = *(const f32x4*)(bias + 8 * fq + 4);
#pragma unroll
        for (int ai = 0; ai < 2; ++ai)
#pragma unroll
          for (int m = 0; m < 4; ++m) {
            f32x4 o0, o1;
            const float rs = sR[ai * 128 + m * 16 + fr];
#pragma unroll
            for (int e = 0; e < 4; ++e) {
              const float v0 = acc[ai][0][m][0][e] * rs + b0[e], v1 = acc[ai][0][m][1][e] * rs + b1[e];
              o0[e] = fmaxf(v0, 0.f) + log1pf(__expf(-fabsf(v0))); o1[e] = fmaxf(v1, 0.f) + log1pf(__expf(-fabsf(v1)));
            }
            float* dp = dt + (size_t)(row0 + ai * HALF + m * 16) * 32 + 8 * fq;
            *(f32x4*)dp = o0; *(f32x4*)(dp + 4) = o1;
          }
      }
      return;
    }
    const int col0 = u.pn * BM + wc * 32 + 8 * fq;
#pragma unroll
    for (int ai = 0; ai < 2; ++ai)
#pragma unroll
      for (int m = 0; m < 4; ++m) {
        bf16_t* rowp = C + (size_t)(row0 + ai * HALF + m * 16) * ldc + col0;
        const float rs = sR[ai * 128 + m * 16 + fr];
#pragma unroll
        for (int bj = 0; bj < 2; ++bj) {
          const f32x4 v0 = acc[ai][bj][m][0] * rs, v1 = acc[ai][bj][m][1] * rs;
          u32x4 w; w[0] = pk2(v0[0], v0[1]); w[1] = pk2(v0[2], v0[3]); w[2] = pk2(v1[0], v1[1]); w[3] = pk2(v1[2], v1[3]);
          *(u32x4*)(rowp + bj * HALF) = w;
        }
      }
  }
};
struct EpiResid {
  static constexpr bool PERM = false, RSTD = false;
  const float* X0; bf16_t* S; float* ssq; bool dry;
  DI void operator()(const f32x4 (&acc)[2][2][4][2], const Unit& u, int wr, int wc, int fr, int fq, const PG8_LAS float* sR) const {
    const int row0 = u.pm * BM + wr * 64 + fr, col0 = u.pn * BM + wc * 32 + 4 * fq;
#pragma unroll
    for (int ai = 0; ai < 2; ++ai) {
      u32x2 sv[4][2][2];
      if (X0 == nullptr) {
#pragma unroll
        for (int m = 0; m < 4; ++m)
#pragma unroll
          for (int bj = 0; bj < 2; ++bj)
#pragma unroll
            for (int n = 0; n < 2; ++n) sv[m][bj][n] = *(const u32x2*)(S + (size_t)(row0 + ai * HALF + m * 16) * 1024 + col0 + bj * HALF + n * 16);
      } else {
#pragma unroll
        for (int m = 0; m < 4; ++m)
#pragma unroll
          for (int bj = 0; bj < 2; ++bj)
#pragma unroll
            for (int n = 0; n < 2; ++n) sv[m][bj][n] = (u32x2){0u, 0u};
      }
#pragma unroll
      for (int m = 0; m < 4; ++m) {
        const int row = row0 + ai * HALF + m * 16;
        const size_t ro = (size_t)row * 1024 + col0;
        float ss = 0.f;
#pragma unroll
        for (int bj = 0; bj < 2; ++bj)
#pragma unroll
          for (int n = 0; n < 2; ++n) {
            f32x4 v;
            if (X0 != nullptr) v = *(const f32x4*)(X0 + ro + bj * HALF + n * 16);
            else { const u32x2 q = sv[m][bj][n]; v[0] = bflo(q[0]); v[1] = bfhi(q[0]); v[2] = bflo(q[1]); v[3] = bfhi(q[1]); }
            v += acc[ai][bj][m][n];
            ss += v[0] * v[0] + v[1] * v[1] + v[2] * v[2] + v[3] * v[3];
            if (!dry) { u32x2 q; q[0] = pk2(v[0], v[1]); q[1] = pk2(v[2], v[3]); *(u32x2*)(S + ro + bj * HALF + n * 16) = q; }
          }
        ss += __shfl_xor(ss, 16); ss += __shfl_xor(ss, 32);
        if (!dry && fq == 0) ssq[(size_t)row * 16 + u.pn * 4 + wc] = ss;
      }
    }
  }
};
struct EpiSwiglu {
  static constexpr bool PERM = false, RSTD = true;
  bf16_t* Hd; const float* ssq;
  DI void operator()(const f32x4 (&acc)[2][2][4][2], const Unit& u, int wr, int wc, int fr, int fq, const PG8_LAS float* sR) const {
    const int row0 = u.pm * BM + wr * 64 + fr, j0 = (u.pn * BM + wc * 32) / 2 + 4 * fq;
#pragma unroll
    for (int ai = 0; ai < 2; ++ai)
#pragma unroll
      for (int m = 0; m < 4; ++m) {
        bf16_t* rowp = Hd + (size_t)(row0 + ai * HALF + m * 16) * 2816 + j0;
        const float rs = sR[ai * 128 + m * 16 + fr];
#pragma unroll
        for (int bj = 0; bj < 2; ++bj) {
          const f32x4 g = acc[ai][bj][m][0] * rs, up = acc[ai][bj][m][1] * rs;
          u32x2 o; o[0] = pk2(silu(g[0]) * up[0], silu(g[1]) * up[1]); o[1] = pk2(silu(g[2]) * up[2], silu(g[3]) * up[3]);
          *(u32x2*)(rowp + bj * (HALF / 2)) = o;
        }
      }
  }
};

template <class Epi>
DI void gemm_phase(PG8_LAS unsigned char* lds, const Gemm g, const StaticOrder& S, const Epi& E) {
  const int tid = otid(), wid = __builtin_amdgcn_readfirstlane(tid >> 6), lane = tid & 63, wr = wid >> 2, wc = wid & 3, fr = lane & 15, fq = lane >> 4;
  const int K = g.K, nt = K / BK;
  unsigned voffA[2], voffB[2];
#pragma unroll
  for (int i = 0; i < 2; ++i) { int R, C; stage_rc(tid * 16 + i * 8192, R, C); const int Rb = Epi::PERM ? ((R & ~31) + perm32(R & 31)) : R;
    voffA[i] = (unsigned)(R * g.lda + C) * 2u; voffB[i] = (unsigned)(Rb * K + C) * 2u; }
  const size_t kstep = (size_t)(BK * 2);
  const size_t hstepA = (size_t)HALF * g.lda * 2, hstepB = (size_t)HALF * K * 2;
  const size_t tstepA = 2 * hstepA, tstepB = 2 * hstepB;
  const unsigned ldsw = (unsigned)wid * 1024u;
  const int aoff = lds_byte(wr * 64 + fr, fq * 8), boff = lds_byte(wc * 32 + fr, fq * 8);
#define PG8_SA(b, h) (((b) * 2 + (h)) * HTB)
#define PG8_SB(b, h) ((4 + (b) * 2 + (h)) * HTB)
#define PG8_STAGE(bufoff, gbase, voff) do { _Pragma("unroll") for (int _i = 0; _i < 2; ++_i) \
    __builtin_amdgcn_global_load_lds((const unsigned*)((const char*)(gbase) + (voff)[_i]), (PG8_LAS unsigned*)(lds + (bufoff) + ldsw + _i * 8192), 16, 0, 0); } while (0)
#define PG8_LDA(dst, b, h) do { _Pragma("unroll") for (int m = 0; m < 4; ++m) _Pragma("unroll") for (int k = 0; k < 2; ++k) dst[m][k] = *(const PG8_LAS bf16x8*)(lds + PG8_SA(b, h) + aoff + m * 2048 + k * 1024); } while (0)
#define PG8_LDB(dst, b, h) do { _Pragma("unroll") for (int n = 0; n < 2; ++n) _Pragma("unroll") for (int k = 0; k < 2; ++k) dst[n][k] = *(const PG8_LAS bf16x8*)(lds + PG8_SB(b, h) + boff + n * 2048 + k * 1024); } while (0)
#define PG8_MMA(ai, bj, At, Bt) do { __builtin_amdgcn_s_setprio(1); _Pragma("unroll") for (int m = 0; m < 4; ++m) _Pragma("unroll") for (int n = 0; n < 2; ++n) _Pragma("unroll") for (int k = 0; k < 2; ++k) \
    acc[ai][bj][m][n] = __builtin_amdgcn_mfma_f32_16x16x32_bf16(Bt[n][k], At[m][k], acc[ai][bj][m][n], 0, 0, 0); __builtin_amdgcn_s_setprio(0); } while (0)
#define PG8_WAIT_V(n) asm volatile("s_waitcnt vmcnt(" #n ")" ::: "memory")
#define PG8_WAIT_L(n) asm volatile("s_waitcnt lgkmcnt(" #n ")" ::: "memory")
#define PG8_BAR __builtin_amdgcn_s_barrier()
#define PG8_SCHED __builtin_amdgcn_sched_barrier(0)
  Unit cur, nxt; int ui = 0;
  if (!S.next(0, cur)) return;
  f32x4 acc[2][2][4][2];
#pragma unroll
  for (int a = 0; a < 2; ++a)
#pragma unroll
    for (int b = 0; b < 2; ++b)
#pragma unroll
      for (int m = 0; m < 4; ++m)
#pragma unroll
        for (int n = 0; n < 2; ++n) acc[a][b][m][n] = (f32x4){0.f, 0.f, 0.f, 0.f};
  bf16x8 At[4][2], B0[2][2], B1[2][2];
  const char* cA = (const char*)g.A + (size_t)cur.pm * tstepA; const char* cB = (const char*)g.Bt + (size_t)cur.pn * tstepB;
  PG8_STAGE(PG8_SB(0, 0), cB, voffB); PG8_STAGE(PG8_SA(0, 0), cA, voffA); PG8_STAGE(PG8_SB(0, 1), cB + hstepB, voffB); PG8_STAGE(PG8_SA(0, 1), cA + hstepA, voffA);
  if (wr == 1) PG8_BAR;
  PG8_WAIT_V(4); PG8_BAR;
  PG8_STAGE(PG8_SB(1, 0), cB + kstep, voffB); PG8_STAGE(PG8_SA(1, 0), cA + kstep, voffA); PG8_STAGE(PG8_SB(1, 1), cB + hstepB + kstep, voffB);
  PG8_WAIT_V(6); PG8_BAR;
  for (;;) {
    const bool has_next = S.next(ui + 1, nxt);
    const char* nA = has_next ? (const char*)g.A + (size_t)nxt.pm * tstepA : cA; const char* nB = has_next ? (const char*)g.Bt + (size_t)nxt.pn * tstepB : cB;
    for (int t = 0; t < nt; t += 2) {
      const bool last = (t == nt - 2);
      const char* a1 = cA + (size_t)(t + 1) * kstep;
      const char* a2 = last ? nA : cA + (size_t)(t + 2) * kstep; const char* b2 = last ? nB : cB + (size_t)(t + 2) * kstep;
      const char* a3 = a2 + kstep; const char* b3 = b2 + kstep;
      PG8_LDB(B0, 0, 0); PG8_SCHED; PG8_LDA(At, 0, 0); PG8_STAGE(PG8_SA(1, 1), a1 + hstepA, voffA);
      PG8_WAIT_L(8); PG8_BAR; PG8_WAIT_L(0); PG8_MMA(0, 0, At, B0); PG8_BAR; PG8_SCHED;
      PG8_LDB(B1, 0, 1); PG8_STAGE(PG8_SB(0, 0), b2, voffB);
      PG8_BAR; PG8_WAIT_L(0); PG8_MMA(0, 1, At, B1); PG8_BAR;
      PG8_LDA(At, 0, 1); PG8_STAGE(PG8_SA(0, 0), a2, voffA);
      PG8_BAR; PG8_WAIT_L(0); PG8_MMA(1, 0, At, B0); PG8_BAR; PG8_SCHED;
      PG8_STAGE(PG8_SB(0, 1), b2 + hstepB, voffB);
      PG8_WAIT_V(6); PG8_BAR; PG8_MMA(1, 1, At, B1); PG8_BAR;
      PG8_LDB(B0, 1, 0); PG8_SCHED; PG8_LDA(At, 1, 0); PG8_STAGE(PG8_SA(0, 1), a2 + hstepA, voffA);
      PG8_WAIT_L(8); PG8_BAR; PG8_WAIT_L(0); PG8_MMA(0, 0, At, B0); PG8_BAR; PG8_SCHED;
      PG8_LDB(B1, 1, 1); PG8_STAGE(PG8_SB(1, 0), b3, voffB);
      PG8_BAR; PG8_WAIT_L(0); PG8_MMA(0, 1, At, B1); PG8_BAR;
      PG8_LDA(At, 1, 1); PG8_STAGE(PG8_SA(1, 0), a3, voffA);
      PG8_BAR; PG8_WAIT_L(0); PG8_MMA(1, 0, At, B0); PG8_BAR; PG8_SCHED;
      PG8_STAGE(PG8_SB(1, 1), b3 + hstepB, voffB);
      PG8_WAIT_V(6); PG8_BAR; PG8_MMA(1, 1, At, B1); PG8_BAR;
    }
    const PG8_LAS float* sR = (const PG8_LAS float*)(lds + 131072) + ui * 256 + wr * 64;
    E(acc, cur, wr, wc, fr, fq, sR);
    if (!has_next) break;
#pragma unroll
    for (int a = 0; a < 2; ++a)
#pragma unroll
      for (int b = 0; b < 2; ++b)
#pragma unroll
        for (int m = 0; m < 4; ++m)
#pragma unroll
          for (int n = 0; n < 2; ++n) acc[a][b][m][n] = (f32x4){0.f, 0.f, 0.f, 0.f};
    cur = nxt; cA = nA; cB = nB; ++ui;
  }
  PG8_WAIT_V(0);
  if (wr == 0) PG8_BAR;
  PG8_BAR;
#undef PG8_SA
#undef PG8_SB
#undef PG8_STAGE
#undef PG8_LDA
#undef PG8_LDB
#undef PG8_MMA
#undef PG8_WAIT_V
#undef PG8_WAIT_L
#undef PG8_BAR
#undef PG8_SCHED
}
}

template <class Epi>
DI void gemm_run(const bf16_t* A, int lda, const bf16_t* Bt, int K, int N, char* lds, const Epi& e) {
  pg8::Gemm g{A, Bt, lda, N, K};
  pg8::StaticOrder S; S.init(T, N, (int)gridDim.x, (int)blockIdx.x);
  if constexpr (Epi::RSTD) {
    __attribute__((address_space(3))) float* sRall = (__attribute__((address_space(3))) float*)(lds + 131072);
    pg8::Unit u;
    const int tq = otid();
    for (int i = tq >> 8; S.next(i, u); i += 2) sRall[i * 256 + (tq & 255)] = pg8::row_rstd(e.ssq, u.pm * 256 + (tq & 255));
  }
  __syncthreads();
  pg8::gemm_phase(( __attribute__((address_space(3))) unsigned char*)lds, g, S, e);
  __syncthreads();
}

DI void init_stream_phase(const float* Xin, bf16_t* S, float* ssq) {
  const int tid = otid(), lane = tid & 63, wave = tid >> 6;
  const int stride = gridDim.x * 8;
  for (int row0 = blockIdx.x * 8 + wave; row0 < T; row0 += stride * 2) {
    f32x4 v[2][4];
#pragma unroll
    for (int k = 0; k < 2; ++k) { const int row = (row0 + k * stride < T) ? row0 + k * stride : row0; const f32x4* xr = (const f32x4*)(Xin + (size_t)row * 1024);
#pragma unroll
      for (int j = 0; j < 4; ++j) v[k][j] = xr[lane + 64 * j]; }
#pragma unroll
    for (int k = 0; k < 2; ++k) {
      const int row = row0 + k * stride;
      if (row < T) {
        float ss = 0.f;
#pragma unroll
        for (int j = 0; j < 4; ++j) ss += v[k][j][0] * v[k][j][0] + v[k][j][1] * v[k][j][1] + v[k][j][2] * v[k][j][2] + v[k][j][3] * v[k][j][3];
        ss = wave_sum(ss);
#pragma unroll
        for (int j = 0; j < 4; ++j) { u32x2 q; q[0] = pk2(v[k][j][0], v[k][j][1]); q[1] = pk2(v[k][j][2], v[k][j][3]); *(u32x2*)(S + (size_t)row * 1024 + 4 * (lane + 64 * j)) = q; }
        if (lane < 16) ssq[(size_t)row * 16 + lane] = (lane == 0) ? ss : 0.f;
      }
    }
  }
}
DI void final_norm_phase(const bf16_t* S, const float* w, float* out) {
  const int tid = otid(), lane = tid & 63, wave = tid >> 6;
  const int stride = gridDim.x * 8;
  f32x4 wv[4];
#pragma unroll
  for (int q = 0; q < 4; ++q) wv[q] = *(const f32x4*)(w + (q >> 1) * 512 + lane * 8 + (q & 1) * 4);
  for (int row0 = blockIdx.x * 8 + wave; row0 < T; row0 += stride * 4) {
    u32x4 r[4][2];
#pragma unroll
    for (int k = 0; k < 4; ++k) { const int row = (row0 + k * stride < T) ? row0 + k * stride : row0;
      r[k][0] = *(const u32x4*)(S + (size_t)row * 1024 + lane * 8); r[k][1] = *(const u32x4*)(S + (size_t)row * 1024 + 512 + lane * 8); }
#pragma unroll
    for (int k = 0; k < 4; ++k) {
      const int row = row0 + k * stride;
      if (row < T) {
        float f[16];
        { float a[8], b2[8]; unpack8(r[k][0], a); unpack8(r[k][1], b2);
#pragma unroll
          for (int e = 0; e < 8; ++e) { f[e] = a[e]; f[8 + e] = b2[e]; } }
        float ss = 0.f;
#pragma unroll
        for (int e = 0; e < 16; ++e) ss += f[e] * f[e];
        ss = wave_sum(ss);
        const float rstd = rsqrtf(ss * (1.f / 1024.f) + 1e-5f);
#pragma unroll
        for (int hlf = 0; hlf < 2; ++hlf) {
          const int c0 = hlf * 512 + lane * 8;
          f32x4 o0, o1;
#pragma unroll
          for (int e = 0; e < 4; ++e) { o0[e] = f[hlf * 8 + e] * rstd * wv[2 * hlf][e]; o1[e] = f[hlf * 8 + 4 + e] * rstd * wv[2 * hlf + 1][e]; }
          *(f32x4*)(out + (size_t)row * 1024 + c0) = o0; *(f32x4*)(out + (size_t)row * 1024 + c0 + 4) = o1;
        }
      }
    }
  }
}

struct CvtJob { const float* src; bf16_t* dst; const float* kscale; int K, N, Npad, mode, ntiles; };
DI CvtJob cvt_job(const float* src, int K, int N, bf16_t* dst, int Npad, int mode, const float* kscale) {
  CvtJob j; j.src = src; j.dst = dst; j.kscale = kscale; j.K = K; j.N = N; j.Npad = Npad; j.mode = mode; j.ntiles = (K >> 6) * ((Npad + 255) >> 8); return j;
}
DI void convert_tile(const CvtJob& jb, int ti, char* lds) {
  float* tile = (float*)lds;
  const int tid = otid();
  const int K = jb.K, N = jb.N;
  const int nkt = K >> 6;
  const int kt = ti % nkt, nt = ti / nkt, k0 = kt * 64, n0 = nt * 256;
  const int nn = tid & 255, kr = tid >> 8;
  const int n = n0 + nn;
  float v[32];
#pragma unroll
  for (int i = 0; i < 32; ++i) v[i] = (n < N) ? jb.src[(size_t)(k0 + kr + 2 * i) * N + n] : 0.f;
#pragma unroll
  for (int i = 0; i < 32; ++i) { const int k = kr + 2 * i; tile[k * 257 + nn] = jb.kscale ? v[i] * jb.kscale[k0 + k] : v[i]; }
  __syncthreads();
#pragma unroll
  for (int j = 0; j < 4; ++j) {
    const int q = tid + 512 * j, nw = q >> 3, kc = q & 7;
    float f[8];
#pragma unroll
    for (int e = 0; e < 8; ++e) f[e] = tile[(kc * 8 + e) * 257 + nw];
    const int nr = n0 + nw;
    if (nr < jb.Npad) {
      const int drow = (jb.mode == 0) ? nr : (32 * (nr >> 4) + (nr & 15) + (jb.mode == 2 ? 16 : 0));
      *(u32x4*)(jb.dst + (size_t)drow * K + k0 + kc * 8) = pack8(f);
    }
  }
  __syncthreads();
}
template <int NJ>
DI void convert_jobs(const CvtJob (&jobs)[NJ], char* lds, int first_blk) {
  if ((int)blockIdx.x < first_blk) return;
  int total = 0;
#pragma unroll
  for (int j = 0; j < NJ; ++j) total += jobs[j].ntiles;
  for (int ti = (int)blockIdx.x - first_blk; ti < total; ti += (int)gridDim.x - first_blk) {
    int rem = ti; bool done = false;
#pragma unroll
    for (int j = 0; j < NJ; ++j) {
      if (!done) { if (rem < jobs[j].ntiles) { convert_tile(jobs[j], rem, lds); done = true; } else rem -= jobs[j].ntiles; }
    }
  }
}
DI void convert_ffn(const Params& p, int L, char* lds, int first_blk) {
  const float* nw2 = p.ffn_norm_w + L * 1024;
  const CvtJob jobs[3] = {
    cvt_job(p.w_gate + (size_t)L * 1024 * 2816, 1024, 2816, p.Wb + W_GU, 2816, 1, nw2), cvt_job(p.w_up + (size_t)L * 1024 * 2816, 1024, 2816, p.Wb + W_GU, 2816, 2, nw2),
    cvt_job(p.w_down + (size_t)L * 2816 * 1024, 2816, 1024, p.Wb + W_DN, 1024, 0, nullptr)};
  convert_jobs(jobs, lds, first_blk);
}
DI void convert_mixer(const Params& p, int L, char* lds, int first_blk) {
  const int i = L >> 1; bf16_t* Wb = p.Wb;
  const float* nw1 = p.mix_norm_w + L * 1024;
  if (!(L & 1)) {
    const CvtJob jobs[6] = {
      cvt_job(p.ap_w_in + (size_t)i * 1024 * 1280, 1024, 1280, Wb + W_IN, 1280, 0, nw1), cvt_job(p.ap_w_out + (size_t)i * 1024 * 1024, 1024, 1024, Wb + W_OUT, 1024, 0, nullptr),
      cvt_job(p.pool_w + (size_t)(i * 4 + 0) * 16384, 128, 128, Wb + W_POOL, 128, 0, nullptr), cvt_job(p.pool_w + (size_t)(i * 4 + 1) * 16384, 128, 128, Wb + W_POOL + 16384, 128, 0, nullptr),
      cvt_job(p.pool_w + (size_t)(i * 4 + 2) * 16384, 128, 128, Wb + W_POOL + 32768, 128, 0, nullptr), cvt_job(p.pool_w + (size_t)(i * 4 + 3) * 16384, 128, 128, Wb + W_POOL + 49152, 128, 0, nullptr)};
    convert_jobs(jobs, lds, first_blk);
  } else {
    const CvtJob jobs[2] = {
      cvt_job(p.ssd_w_in + (size_t)i * 1024 * 5152, 1024, 5152, Wb + W_IN, 5376, 0, nw1), cvt_job(p.ssd_w_out + (size_t)i * 2048 * 1024, 2048, 1024, Wb + W_OUT, 1024, 0, nullptr)};
    convert_jobs(jobs, lds, first_blk);
  }
}
DI int idle_from(int nunits) { const int r = nunits % (int)gridDim.x; return r; }

#define LDS_BARRIER() do { asm volatile("s_waitcnt lgkmcnt(0)" ::: "memory"); __builtin_amdgcn_s_barrier(); asm volatile("" ::: "memory"); } while (0)
DI void attn_phase(const bf16_t* proj, bf16_t* cat, const float* sinks, char* lds) {
  char* sK = lds; char* sVt = lds + 32768;
  const int tid = otid(), lane = tid & 63, wave = tid >> 6, h = lane >> 5, l31 = lane & 31;
  const int swz = (lane >> 1) & 7;
  for (int item = blockIdx.x; item < 256; item += gridDim.x) {
    const int kvh = item & 1, nb = (item >> 1) & 63, b = item >> 7;
    const int tok0 = b * SEQ + nb * 128;
    u32x4 kv[8];
#pragma unroll
    for (int j = 0; j < 4; ++j) {
      const int q = tid + 512 * j;
      { const int key = q >> 3, c = q & 7; const bool ok = (nb > 0 || key >= 128);
        kv[j] = *(const u32x4*)(proj + (size_t)(ok ? (tok0 - 128 + key) : tok0) * 1280 + 512 + kvh * 64 + c * 8); }
      { const int key = q & 255, c = q >> 8; const bool ok = (nb > 0 || key >= 128);
        kv[4 + j] = *(const u32x4*)(proj + (size_t)(ok ? (tok0 - 128 + key) : tok0) * 1280 + 640 + kvh * 64 + c * 8); }
    }
#pragma unroll
    for (int j = 0; j < 4; ++j) {
      const int q = tid + 512 * j, key = q >> 3, c = q & 7;
      u32x4 v = kv[j];
      if (!(nb > 0 || key >= 128)) v = (u32x4){0u, 0u, 0u, 0u};
      *(u32x4*)(sK + swz64(key, c)) = v;
    }
#pragma unroll
    for (int j = 0; j < 4; ++j) {
      const int q = tid + 512 * j, key = q & 255, c = q >> 8;
      u32x4 v = kv[4 + j];
      if (!(nb > 0 || key >= 128)) v = (u32x4){0u, 0u, 0u, 0u};
#pragma unroll
      for (int e = 0; e < 8; ++e) *(bf16_t*)(sVt + (c * 8 + e) * 520 + key * 2) = (bf16_t)(v[e >> 1] >> (16 * (e & 1)));
    }
    __syncthreads();
#pragma unroll 1
    for (int task = 0; task < 2; ++task) {
      const int g = wave >> 1, sb = (wave & 1) * 2 + task, head = kvh * 4 + g, q0 = sb * 32;
      const int qi = q0 + l31;
      const size_t qtok = (size_t)tok0 + qi;
      bf16x8 qf[4];
#pragma unroll
      for (int kk = 0; kk < 4; ++kk) qf[kk] = *(const bf16x8*)(proj + qtok * 1280 + head * 64 + kk * 16 + 8 * h);
      f32x16 s[5];
#pragma unroll
      for (int t = 0; t < 5; ++t) {
#pragma unroll
        for (int i = 0; i < 16; ++i) s[t][i] = 0.f;
        const char* kp = sK + (32 * (sb + t) + l31) * 128;
#pragma unroll
        for (int kk = 0; kk < 4; ++kk) { const bf16x8 kf = *(const bf16x8*)(kp + (((kk * 2 + h) ^ swz) << 4)); s[t] = MFMA(kf, qf[kk], s[t]); }
      }
      const float sink = sinks[head];
      float mx = sink;
#pragma unroll
      for (int t = 0; t < 5; ++t)
#pragma unroll
        for (int i = 0; i < 16; ++i) {
          const float pen = (nb > 0 || sb + t >= 4) ? 0.f : -1e30f;
          float sv = s[t][i] * 0.125f + pen;
          if (t == 0) sv = (crow(i, h) > l31) ? sv : -1e30f;
          if (t == 4) sv = (crow(i, h) <= l31) ? sv : -1e30f;
          s[t][i] = sv; mx = fmaxf(mx, sv);
        }
      mx = fmaxf(mx, __shfl_xor(mx, 32));
      float sum = 0.f;
#pragma unroll
      for (int t = 0; t < 5; ++t)
#pragma unroll
        for (int i = 0; i < 16; ++i) { const float pv = __expf(s[t][i] - mx); s[t][i] = pv; sum += pv; }
      sum += __shfl_xor(sum, 32);
      sum += __expf(sink - mx);
      f32x16 o[2];
#pragma unroll
      for (int mi = 0; mi < 2; ++mi)
#pragma unroll
        for (int i = 0; i < 16; ++i) o[mi][i] = 0.f;
#pragma unroll
      for (int t = 0; t < 5; ++t)
#pragma unroll
        for (int s2 = 0; s2 < 2; ++s2) {
          u32x4 pp;
#pragma unroll
          for (int e = 0; e < 4; ++e) pp[e] = pk2(s[t][8 * s2 + 2 * e], s[t][8 * s2 + 2 * e + 1]);
          const bf16x8 pf = __builtin_bit_cast(bf16x8, pp);
#pragma unroll
          for (int mi = 0; mi < 2; ++mi) {
            const char* vp = sVt + (mi * 32 + l31) * 520 + (32 * (sb + t) + 16 * s2 + 4 * h) * 2;
            const s16x4 lo = *(const s16x4*)vp; const s16x4 hi = *(const s16x4*)(vp + 16);
            const bf16x8 vf = __builtin_shufflevector(lo, hi, 0, 1, 2, 3, 4, 5, 6, 7);
            o[mi] = MFMA(vf, pf, o[mi]);
          }
        }
      const float inv = 1.f / sum;
#pragma unroll
      for (int mi = 0; mi < 2; ++mi)
#pragma unroll
        for (int gi = 0; gi < 4; ++gi) {
          u32x2 ov; ov[0] = pk2(o[mi][4 * gi] * inv, o[mi][4 * gi + 1] * inv); ov[1] = pk2(o[mi][4 * gi + 2] * inv, o[mi][4 * gi + 3] * inv);
          *(u32x2*)(cat + qtok * 1024 + head * 64 + mi * 32 + 8 * gi + 4 * h) = ov;
        }
    }
    __syncthreads();
  }
}

template <int W, int UB>
DI void pool_fill(const bf16_t* proj, const bf16_t* Wp, char* sD, char* sW, int tid, int t0, int tin0, int g) {
#pragma unroll 1
  for (int jb = 0; jb < 4; jb += UB) {
    u32x4 cu[UB], rr[UB][W - 1], wv[UB];
#pragma unroll
    for (int u = 0; u < UB; ++u) {
      const int q = tid + 512 * (jb + u), tok = q >> 4, c = q & 15, tin = tin0 + tok;
      const bf16_t* pp = proj + (size_t)(t0 + tok) * 1280 + 768 + g * 128 + c * 8;
      cu[u] = *(const u32x4*)pp;
#pragma unroll
      for (int i = 1; i < W; ++i) rr[u][i - 1] = *(const u32x4*)(pp - (size_t)((i <= tin) ? i : 0) * 1280);
      wv[u] = *(const u32x4*)(Wp + (size_t)g * 16384 + tok * 128 + c * 8);
    }
#pragma unroll
    for (int u = 0; u < UB; ++u) {
      const int q = tid + 512 * (jb + u), tok = q >> 4, c = q & 15, tin = tin0 + tok;
      float cur[8], sum[8], d[8];
      unpack8(cu[u], cur);
#pragma unroll
      for (int e = 0; e < 8; ++e) sum[e] = cur[e];
#pragma unroll
      for (int i = 1; i < W; ++i) {
        float f[8]; unpack8(rr[u][i - 1], f);
        const float m = (i <= tin) ? 1.f : 0.f;
#pragma unroll
        for (int e = 0; e < 8; ++e) sum[e] += m * f[e];
      }
      const int cnt = (tin + 1 < W) ? (tin + 1) : W;
      const float ic = 1.f / (float)cnt;
#pragma unroll
      for (int e = 0; e < 8; ++e) d[e] = sum[e] * ic - cur[e];
      *(u32x4*)(sD + swz128(tok, c)) = pack8(d);
      *(u32x4*)(sW + swz128(tok, c)) = wv[u];
    }
  }
}
DI void pool_phase(const bf16_t* proj, bf16_t* cat, const bf16_t* Wp, const float* scale, char* lds) {
  char* sD = lds; char* sW = lds + 32768;
  const int tid = otid(), lane = tid & 63, wave = tid >> 6, h = lane >> 5, l31 = lane & 31;
  for (int item = blockIdx.x; item < 512; item += gridDim.x) {
    const int g = item & 3, tt = item >> 2, t0 = tt * 128, tin0 = t0 & (SEQ - 1);
    if (g == 0) pool_fill<2, 4>(proj, Wp, sD, sW, tid, t0, tin0, g); else if (g == 1) pool_fill<4, 4>(proj, Wp, sD, sW, tid, t0, tin0, g);
    else if (g == 2) pool_fill<8, 2>(proj, Wp, sD, sW, tid, t0, tin0, g); else pool_fill<16, 1>(proj, Wp, sD, sW, tid, t0, tin0, g);
    __syncthreads();
    const int tk = wave & 3, dt0 = (wave >> 2) * 2;
    f32x16 acc[2];
#pragma unroll
    for (int e = 0; e < 2; ++e)
#pragma unroll
      for (int i = 0; i < 16; ++i) acc[e][i] = 0.f;
#pragma unroll
    for (int kk = 0; kk < 8; ++kk) {
      const bf16x8 yf = *(const bf16x8*)(sD + swz128(32 * tk + l31, 2 * kk + h));
#pragma unroll
      for (int e = 0; e < 2; ++e) {
        const bf16x8 xf = *(const bf16x8*)(sW + swz128(32 * (dt0 + e) + l31, 2 * kk + h));
        acc[e] = MFMA(xf, yf, acc[e]);
      }
    }
    const size_t tok = (size_t)t0 + 32 * tk + l31;
#pragma unroll
    for (int e = 0; e < 2; ++e)
#pragma unroll
      for (int gi = 0; gi < 4; ++gi) {
        const int dout = 32 * (dt0 + e) + 8 * gi + 4 * h;
        const f32x4 sc = *(const f32x4*)(scale + g * 128 + dout);
        u32x2 ov; ov[0] = pk2(acc[e][4 * gi] * sc[0], acc[e][4 * gi + 1] * sc[1]); ov[1] = pk2(acc[e][4 * gi + 2] * sc[2], acc[e][4 * gi + 3] * sc[3]);
        *(u32x2*)(cat + tok * 1024 + 512 + g * 128 + dout) = ov;
      }
    LDS_BARRIER();
  }
}

DI void conv8(const bf16_t* P, size_t tok, int tin, int col, const float* cw, const float* cb, float (&out)[8]) {
  float a[8];
  { const f32x4 b0 = *(const f32x4*)(cb + col), b1 = *(const f32x4*)(cb + col + 4);
    a[0] = b0[0]; a[1] = b0[1]; a[2] = b0[2]; a[3] = b0[3]; a[4] = b1[0]; a[5] = b1[1]; a[6] = b1[2]; a[7] = b1[3]; }
  u32x4 raw[4];
#pragma unroll
  for (int kk = 0; kk < 4; ++kk) raw[kk] = *(const u32x4*)(P + (tok - ((tin - 3 + kk >= 0) ? (3 - kk) : 0)) * 5120 + 2048 + col);
#pragma unroll
  for (int kk = 0; kk < 4; ++kk) {
    float f[8]; unpack8(raw[kk], f);
    const float ok = (tin - 3 + kk >= 0) ? 1.f : 0.f;
    const f32x4 w0 = *(const f32x4*)(cw + kk * 3072 + col) * ok, w1 = *(const f32x4*)(cw + kk * 3072 + col + 4) * ok;
    a[0] += w0[0] * f[0]; a[1] += w0[1] * f[1]; a[2] += w0[2] * f[2]; a[3] += w0[3] * f[3];
    a[4] += w1[0] * f[4]; a[5] += w1[1] * f[5]; a[6] += w1[2] * f[6]; a[7] += w1[3] * f[7];
  }
#pragma unroll
  for (int e = 0; e < 8; ++e) out[e] = silu(a[e]);
}

DI void ssd_cb_phase(const bf16_t* P, bf16_t* BT, bf16_t* Cc, bf16_t* CB, const float* dt, float* acs,
                     const float* cw, const float* cb, const float* A_log, char* lds) {
  char* sB = lds; char* sC = lds + 32768;
  const int tid = otid(), lane = tid & 63, wave = tid >> 6, h = lane >> 5, l31 = lane & 31;
  for (int item = blockIdx.x; item < 512; item += gridDim.x) {
    const int g = item & 3, c = (item >> 2) & 63, b = item >> 8;
    const size_t t0 = (size_t)b * SEQ + c * 128;
    const int tin0 = c * 128;
    bf16_t* BTi = BT + (size_t)item * 16384; bf16_t* Cci = Cc + (size_t)item * 16384; bf16_t* CBi = CB + (size_t)item * 16384;
    float* sW = (float*)(lds + 65536);
    u32x4 raw[4][4];
#pragma unroll
    for (int j = 0; j < 4; ++j) {
      const int q = tid + 512 * j;
      const int lb = q & 127, cb8 = q >> 7;
#pragma unroll
      for (int kk = 0; kk < 4; ++kk) raw[j][kk] = *(const u32x4*)(P + (t0 + lb - ((tin0 + lb - 3 + kk >= 0) ? (3 - kk) : 0)) * 5120 + 2048 + 2048 + g * 128 + cb8 * 8);
    }
    for (int q = tid; q < 1280; q += 512) { const int which = q / 640, r = q % 640, kk = r >> 7, col = 2048 + which * 512 + g * 128 + (r & 127); sW[q] = (kk < 4) ? cw[kk * 3072 + col] : cb[col]; }
    LDS_BARRIER();
#pragma unroll
    for (int j = 0; j < 4; ++j) {
      const int q = tid + 512 * j, l = q & 127, cch = q >> 7;
      float v[8];
      { const f32x4 b0 = *(const f32x4*)(sW + 512 + cch * 8), b1 = *(const f32x4*)(sW + 512 + cch * 8 + 4);
        v[0] = b0[0]; v[1] = b0[1]; v[2] = b0[2]; v[3] = b0[3]; v[4] = b1[0]; v[5] = b1[1]; v[6] = b1[2]; v[7] = b1[3]; }
#pragma unroll
      for (int kk = 0; kk < 4; ++kk) {
        float f[8]; unpack8(raw[j][kk], f);
        const float ok = (tin0 + l - 3 + kk >= 0) ? 1.f : 0.f;
        const f32x4 w0 = *(const f32x4*)(sW + kk * 128 + cch * 8) * ok, w1 = *(const f32x4*)(sW + kk * 128 + cch * 8 + 4) * ok;
        v[0] += w0[0] * f[0]; v[1] += w0[1] * f[1]; v[2] += w0[2] * f[2]; v[3] += w0[3] * f[3];
        v[4] += w1[0] * f[4]; v[5] += w1[1] * f[5]; v[6] += w1[2] * f[6]; v[7] += w1[3] * f[7];
      }
#pragma unroll
      for (int e = 0; e < 8; ++e) v[e] = silu(v[e]);
      const u32x4 pk = pack8(v);
      *(u32x4*)(sB + swz128(l, cch)) = pk;
#pragma unroll
      for (int e = 0; e < 8; ++e) BTi[(cch * 8 + e) * 128 + l] = (bf16_t)(pk[e >> 1] >> (16 * (e & 1)));
      { const int lc = q >> 4, cc8 = q & 15;
#pragma unroll
        for (int kk = 0; kk < 4; ++kk) raw[j][kk] = *(const u32x4*)(P + (t0 + lc - ((tin0 + lc - 3 + kk >= 0) ? (3 - kk) : 0)) * 5120 + 2048 + 2560 + g * 128 + cc8 * 8); }
    }
#pragma unroll
    for (int j = 0; j < 4; ++j) {
      const int q = tid + 512 * j, l = q >> 4, cch = q & 15;
      float v[8];
      { const f32x4 b0 = *(const f32x4*)(sW + 640 + 512 + cch * 8), b1 = *(const f32x4*)(sW + 640 + 512 + cch * 8 + 4);
        v[0] = b0[0]; v[1] = b0[1]; v[2] = b0[2]; v[3] = b0[3]; v[4] = b1[0]; v[5] = b1[1]; v[6] = b1[2]; v[7] = b1[3]; }
#pragma unroll
      for (int kk = 0; kk < 4; ++kk) {
        float f[8]; unpack8(raw[j][kk], f);
        const float ok = (tin0 + l - 3 + kk >= 0) ? 1.f : 0.f;
        const f32x4 w0 = *(const f32x4*)(sW + 640 + kk * 128 + cch * 8) * ok, w1 = *(const f32x4*)(sW + 640 + kk * 128 + cch * 8 + 4) * ok;
        v[0] += w0[0] * f[0]; v[1] += w0[1] * f[1]; v[2] += w0[2] * f[2]; v[3] += w0[3] * f[3];
        v[4] += w1[0] * f[4]; v[5] += w1[1] * f[5]; v[6] += w1[2] * f[6]; v[7] += w1[3] * f[7];
      }
#pragma unroll
      for (int e = 0; e < 8; ++e) v[e] = silu(v[e]);
      const u32x4 pk = pack8(v);
      *(u32x4*)(sC + swz128(l, cch)) = pk;
      *(u32x4*)(Cci + l * 128 + cch * 8) = pk;
    }
    {
      const int hh = 8 * g + wave;
      const float Ah = -__expf(A_log[hh]);
      const int l0 = 2 * lane;
      const float d0 = dt[(t0 + l0) * 32 + hh] * Ah, d1 = dt[(t0 + l0 + 1) * 32 + hh] * Ah;
      float sc = d0 + d1;
#pragma unroll
      for (int o = 1; o < 64; o <<= 1) { const float v = __shfl_up(sc, o); if (lane >= o) sc += v; }
      acs[(t0 + l0) * 32 + hh] = sc - d1;
      acs[(t0 + l0 + 1) * 32 + hh] = sc;
    }
    LDS_BARRIER();
    const int lt = wave & 3, st0 = (wave >> 2) * 2;
    f32x16 acc[2];
#pragma unroll
    for (int e = 0; e < 2; ++e)
#pragma unroll
      for (int i = 0; i < 16; ++i) acc[e][i] = 0.f;
#pragma unroll
    for (int kk = 0; kk < 8; ++kk) {
      const bf16x8 yf = *(const bf16x8*)(sC + swz128(32 * lt + l31, 2 * kk + h));
#pragma unroll
      for (int e = 0; e < 2; ++e) {
        const bf16x8 xf = *(const bf16x8*)(sB + swz128(32 * (st0 + e) + l31, 2 * kk + h));
        acc[e] = MFMA(xf, yf, acc[e]);
      }
    }
    const int l = 32 * lt + l31;
#pragma unroll
    for (int e = 0; e < 2; ++e)
#pragma unroll
      for (int gi = 0; gi < 4; ++gi) {
        const int s = 32 * (st0 + e) + 8 * gi + 4 * h;
        u32x2 ov; ov[0] = pk2(acc[e][4 * gi], acc[e][4 * gi + 1]); ov[1] = pk2(acc[e][4 * gi + 2], acc[e][4 * gi + 3]);
        *(u32x2*)(CBi + l * 128 + s) = ov;
      }
    LDS_BARRIER();
  }
}

DI void ssd_scan_phase(bf16_t* P, const bf16_t* BT, const bf16_t* Cc, const bf16_t* CB, const float* dt, const float* acs,
                       const float* cw, const float* cb, const float* Dp, char* lds, bool dry, int mode, float* Sbuf) {
  char* sCBL = lds; char* sC = lds + 32768; char* sBT = lds + 65536; char* sXdt = lds + 98304; char* sXds = lds + 106496;
  char* sSt = lds + 114688;
  char* sXs = lds + 131072;
  float* sAcs = (float*)(lds + 141312);
  float* sDt = (float*)(lds + 142336);
  float* sCw = (float*)(lds + 143360);
  const int tid = otid(), lane = tid & 63, wave = tid >> 6, h = lane >> 5, l31 = lane & 31;
  const int r0_ = tid >> 4, cch_ = tid & 15, r0 = r0_, cch = cch_;
  const int xl_ = 2 * ((tid - 256) & 63), xc_ = (tid - 256) >> 6, xl = xl_, xc = xc_;
  for (int item0 = blockIdx.x; item0 < 256; item0 += gridDim.x) {
    const int item = item0 & 127, seg = item0 >> 7, c0 = mode ? seg * 16 : seg * 32, c1 = c0 + (mode ? 16 : 32);
    const bool zero_init = (mode == 1) || (seg == 0);
    const int grp = item & 7, mem = (item >> 3) & 15, b = grp >> 2, g = grp & 3, hh = 8 * g + (mem >> 1), ph = mem & 1;
    const int pcol = hh * 64 + ph * 32;
    const float Dh = Dp[hh];
    f32x16 st;
#pragma unroll
    for (int i = 0; i < 16; ++i) st[i] = 0.f;
    if (zero_init) { for (int q = tid; q < 2048; q += 512) ((unsigned*)sSt)[q] = 0u; }
    else if (wave >= 4) {
      float dsum = 0.f;
      for (int cc = 16; cc < 32; ++cc) dsum += acs[((size_t)b * SEQ + cc * 128 + 127) * 32 + hh];
      const float Db = __expf(dsum);
      const float* spa = Sbuf + ((size_t)item * 4 + (wave - 4)) * 1024 + lane * 16;
      const float* spb = spa + (size_t)128 * 4 * 1024;
#pragma unroll
      for (int gi = 0; gi < 4; ++gi) { const f32x4 va = *(const f32x4*)(spa + 4 * gi), vb = *(const f32x4*)(spb + 4 * gi); const f32x4 v = va * Db + vb;
        st[4 * gi] = v[0]; st[4 * gi + 1] = v[1]; st[4 * gi + 2] = v[2]; st[4 * gi + 3] = v[3];
        u32x2 ov; ov[0] = pk2(v[0], v[1]); ov[1] = pk2(v[2], v[3]);
        *(u32x2*)(sSt + l31 * 256 + (((4 * (wave - 4) + gi) ^ (l31 & 15)) << 4) + 8 * h) = ov; }
    }
    if (tid < 160) sCw[tid] = (tid < 128) ? cw[(tid >> 5) * 3072 + pcol + (tid & 31)] : cb[pcol + tid - 128];
    const size_t tb = (size_t)b * SEQ, tbs = tb + (size_t)c0 * 128;
    const size_t cbi0 = ((size_t)(b * 64) * 4 + g) * 16384;
    const unsigned toff = r0 * 128 + cch * 8;
    const unsigned xoff = xl * 5120 + xc * 8;
    const unsigned zoff = (32 * (wave & 3) + l31) * 5120 + 4 * h;
    u32x4 rC[4], rB[4], rCB[4], rX[5];
    u32x2 cz[4];
    float racs = 0.f, rdt = 0.f;
    unsigned tchA = 0u, tchB = 0u, tsum = 0u;
    {
      const size_t cbis = cbi0 + (size_t)c0 * 65536;
      const bf16_t* Cq = Cc + cbis; const bf16_t* Bq = BT + cbis; const bf16_t* CBq = CB + cbis;
#pragma unroll
      for (int j = 0; j < 4; ++j) { rB[j] = *(const u32x4*)(Bq + toff + j * 4096); rC[j] = (u32x4){0u, 0u, 0u, 0u}; rCB[j] = (u32x4){0u, 0u, 0u, 0u};
        if (mode == 0) { rC[j] = *(const u32x4*)(Cq + toff + j * 4096); rCB[j] = *(const u32x4*)(CBq + toff + j * 4096); } }
      const bf16_t* Xq = P + tbs * 5120 + 2048 + pcol;
#pragma unroll
      for (int kk = 0; kk < 5; ++kk) {
        rX[kk] = (u32x4){0u, 0u, 0u, 0u};
        if (wave >= 4 && (c0 > 0 || xl - 3 + kk >= 0)) rX[kk] = *(const u32x4*)(Xq + (xl - 3 + kk) * 5120 + xc * 8);
      }
      const bf16_t* Zq = P + tbs * 5120 + pcol;
#pragma unroll
      for (int gi = 0; gi < 4; ++gi) cz[gi] = (u32x2){0u, 0u};
      if (wave < 4 && mode == 0) {
#pragma unroll
        for (int gi = 0; gi < 4; ++gi) cz[gi] = *(const u32x2*)(Zq + zoff + 8 * gi);
      }
      const float* aq = acs + tbs * 32 + hh; const float* dq = dt + tbs * 32 + hh;
      if (tid < 128) { sAcs[tid] = aq[tid * 32]; sDt[tid] = dq[tid * 32]; racs = aq[4096 + tid * 32]; rdt = dq[4096 + tid * 32]; }
    }
    __syncthreads();
#pragma unroll 1
    for (int c = c0; c < c1; ++c) {
      const size_t t0 = tb + c * 128;
      const float* cAcs = sAcs + (c & 1) * 128; const float* cDt = sDt + (c & 1) * 128;
      {
        int xl = xl_, xc = xc_, r0 = r0_, cch = cch_;
        asm volatile("" : "+v"(xl), "+v"(xc), "+v"(r0), "+v"(cch));
        const f32x4 a0 = *(const f32x4*)(cAcs + cch * 8), a1 = *(const f32x4*)(cAcs + cch * 8 + 4);
        const float L2E = 1.44269504f;
        const float as[8] = {a0[0] * L2E, a0[1] * L2E, a0[2] * L2E, a0[3] * L2E, a1[0] * L2E, a1[1] * L2E, a1[2] * L2E, a1[3] * L2E};
#pragma unroll
        for (int j = 0; j < 4; ++j) {
          const int r = r0 + 32 * j;
          *(u32x4*)(sBT + swz128(r, cch)) = rB[j];
          if (mode == 0) {
            *(u32x4*)(sC + swz128(r, cch)) = rC[j];
            float f[8]; unpack8(rCB[j], f);
            const float el = cAcs[r] * L2E;
            const int lim = r - cch * 8;
#pragma unroll
            for (int e = 0; e < 8; ++e) f[e] = (e <= lim) ? f[e] * __builtin_amdgcn_exp2f(el - as[e]) : 0.f;
            *(u32x4*)(sCBL + swz128(r, cch)) = pack8(f);
          }
        }
        if (wave >= 4) {
          float a[8], bq[8];
          { const f32x4 b0 = *(const f32x4*)(sCw + 128 + xc * 8), b1 = *(const f32x4*)(sCw + 128 + xc * 8 + 4);
            a[0] = b0[0]; a[1] = b0[1]; a[2] = b0[2]; a[3] = b0[3]; a[4] = b1[0]; a[5] = b1[1]; a[6] = b1[2]; a[7] = b1[3]; }
#pragma unroll
          for (int e = 0; e < 8; ++e) bq[e] = a[e];
#pragma unroll
          for (int kk = 0; kk < 4; ++kk) {
            float f[8], f2[8]; unpack8(rX[kk], f); unpack8(rX[kk + 1], f2);
            const f32x4 w0 = *(const f32x4*)(sCw + kk * 32 + xc * 8), w1 = *(const f32x4*)(sCw + kk * 32 + xc * 8 + 4);
            a[0] += w0[0] * f[0]; a[1] += w0[1] * f[1]; a[2] += w0[2] * f[2]; a[3] += w0[3] * f[3];
            a[4] += w1[0] * f[4]; a[5] += w1[1] * f[5]; a[6] += w1[2] * f[6]; a[7] += w1[3] * f[7];
            bq[0] += w0[0] * f2[0]; bq[1] += w0[1] * f2[1]; bq[2] += w0[2] * f2[2]; bq[3] += w0[3] * f2[3];
            bq[4] += w1[0] * f2[4]; bq[5] += w1[1] * f2[5]; bq[6] += w1[2] * f2[6]; bq[7] += w1[3] * f2[7];
          }
#pragma unroll
          for (int e = 0; e < 8; ++e) { a[e] = silu(a[e]); bq[e] = silu(bq[e]); }
          if (mode == 0) { *(u32x4*)(sXs + xl * 80 + xc * 16) = pack8(a); *(u32x4*)(sXs + (xl + 1) * 80 + xc * 16) = pack8(bq); }
          const float e127 = cAcs[127];
          const float dlA = cDt[xl], dlB = cDt[xl + 1];
          const float dsA = dlA * __expf(e127 - cAcs[xl]), dsB = dlB * __expf(e127 - cAcs[xl + 1]);
#pragma unroll
          for (int e = 0; e < 8; ++e) {
            const int pr = xc * 8 + e;
            const int off = pr * 256 + (((xl >> 3) ^ (pr & 15)) << 4) + (xl & 7) * 2;
            if (mode == 0) *(unsigned*)(sXdt + off) = pk2(a[e] * dlA, bq[e] * dlB);
            *(unsigned*)(sXds + off) = pk2(a[e] * dsA, bq[e] * dsB);
          }
        }
      }
      float nacs = 0.f, ndt = 0.f;
      tsum += tchA + tchB;
      if (c + 2 < c1) {
        const size_t cb2 = cbi0 + (size_t)(c + 2) * 65536;
        const int tl = tid & 255;
        if (mode == 0 || tid >= 256) tchA = *(const unsigned*)((tid < 256 ? Cc : BT) + cb2 + tl * 64);
        const bf16_t* rowp = P + (t0 + 256 + (tid & 127)) * 5120 + pcol + ((tid < 384) ? 2048 : 0);
        if (mode == 0 || (tid >= 256 && tid < 384)) tchB = *(const unsigned*)((tid < 256) ? (CB + cb2 + tl * 64) : rowp);
      }
      if (c + 1 < c1) {
        if (c + 2 < c1 && tid < 128) { nacs = (acs + (t0 + 256) * 32 + hh)[tid * 32]; ndt = (dt + (t0 + 256) * 32 + hh)[tid * 32]; }
        const size_t cbi = cbi0 + (size_t)(c + 1) * 65536;
        const bf16_t* Cq = Cc + cbi; const bf16_t* Bq = BT + cbi; const bf16_t* CBq = CB + cbi;
#pragma unroll
        for (int j = 0; j < 4; ++j) { rB[j] = *(const u32x4*)(Bq + toff + j * 4096); if (mode == 0) { rC[j] = *(const u32x4*)(Cq + toff + j * 4096); rCB[j] = *(const u32x4*)(CBq + toff + j * 4096); } }
        const bf16_t* Xq = P + (t0 + 125) * 5120 + 2048 + pcol;
#pragma unroll
        for (int kk = 0; kk < 5; ++kk) { if (wave >= 4) rX[kk] = *(const u32x4*)(Xq + xoff + kk * 5120); }
      }
      __builtin_amdgcn_sched_barrier(0);
      LDS_BARRIER();
      int lq = l31, hq = h;
      asm volatile("" : "+v"(lq), "+v"(hq));
      if (wave < 4) {
       if (mode == 0) {
        const int lt = wave;
        f32x16 ad, ao;
#pragma unroll
        for (int i = 0; i < 16; ++i) { ad[i] = 0.f; ao[i] = 0.f; }
        const char* stb = sSt + (c & 1) * 8192;
#pragma unroll
        for (int kk = 0; kk < 8; ++kk) {
          const bf16x8 yf = *(const bf16x8*)(sCBL + swz128(32 * lt + lq, 2 * kk + hq));
          const bf16x8 xf = *(const bf16x8*)(sXdt + swz128(lq, 2 * kk + hq));
          ad = MFMA(xf, yf, ad);
          const bf16x8 yf2 = *(const bf16x8*)(sC + swz128(32 * lt + lq, 2 * kk + hq));
          const bf16x8 xf2 = *(const bf16x8*)(stb + swz128(lq, 2 * kk + hq));
          ao = MFMA(xf2, yf2, ao);
        }
        const int l = 32 * lt + l31;
        const float eo = __expf(cAcs[l]);
        bf16_t* Zq = P + t0 * 5120 + pcol;
#pragma unroll
        for (int gi = 0; gi < 4; ++gi) {
          const int p0 = 8 * gi + 4 * h;
          const u32x2 xsv = *(const u32x2*)(sXs + l * 80 + p0 * 2);
          const u32x2 zv = cz[gi];
          const float xs0 = bflo(xsv[0]), xs1 = bfhi(xsv[0]), xs2 = bflo(xsv[1]), xs3 = bfhi(xsv[1]);
          const float z0 = bflo(zv[0]), z1 = bfhi(zv[0]), z2 = bflo(zv[1]), z3 = bfhi(zv[1]);
          const float y0 = (ad[4 * gi] + eo * ao[4 * gi] + Dh * xs0) * silu(z0);
          const float y1 = (ad[4 * gi + 1] + eo * ao[4 * gi + 1] + Dh * xs1) * silu(z1);
          const float y2 = (ad[4 * gi + 2] + eo * ao[4 * gi + 2] + Dh * xs2) * silu(z2);
          const float y3 = (ad[4 * gi + 3] + eo * ao[4 * gi + 3] + Dh * xs3) * silu(z3);
          u32x2 ov; ov[0] = pk2(y0, y1); ov[1] = pk2(y2, y3);
          if (!dry) *(u32x2*)(Zq + zoff + 8 * gi) = ov;
        }
        if (c + 1 < c1) {
#pragma unroll
          for (int gi = 0; gi < 4; ++gi) cz[gi] = *(const u32x2*)(Zq + 128 * 5120 + zoff + 8 * gi);
        }
       }
      } else {
        const int nt = wave - 4;
        const float dec = __expf(cAcs[127]);
#pragma unroll
        for (int i = 0; i < 16; ++i) st[i] *= dec;
#pragma unroll
        for (int kk = 0; kk < 8; ++kk) {
          const bf16x8 xf = *(const bf16x8*)(sBT + swz128(32 * nt + lq, 2 * kk + hq));
          const bf16x8 yf = *(const bf16x8*)(sXds + swz128(lq, 2 * kk + hq));
          st = MFMA(xf, yf, st);
        }
        char* stn = sSt + ((c + 1) & 1) * 8192;
#pragma unroll
        for (int gi = 0; gi < 4; ++gi) {
          u32x2 ov; ov[0] = pk2(st[4 * gi], st[4 * gi + 1]); ov[1] = pk2(st[4 * gi + 2], st[4 * gi + 3]);
          *(u32x2*)(stn + l31 * 256 + (((4 * nt + gi) ^ (l31 & 15)) << 4) + 8 * h) = ov;
        }
      }
      if (tid < 128) { sAcs[((c + 1) & 1) * 128 + tid] = racs; sDt[((c + 1) & 1) * 128 + tid] = rdt; }
      racs = nacs; rdt = ndt;
      LDS_BARRIER();
    }
    if (mode == 1 && wave >= 4) {
      float* sp = Sbuf + ((size_t)(seg * 128 + item) * 4 + (wave - 4)) * 1024 + lane * 16;
#pragma unroll
      for (int gi = 0; gi < 4; ++gi) { f32x4 v; v[0] = st[4 * gi]; v[1] = st[4 * gi + 1]; v[2] = st[4 * gi + 2]; v[3] = st[4 * gi + 3]; *(f32x4*)(sp + 4 * gi) = v; }
    }
    __syncthreads();
    if (tsum == 0x9e3779b9u && dry) sDt[0] = 1.f;
  }
}

DI void gnorm_phase(bf16_t* P, const float* nw, bool dry) {
  const int tid = otid(), lane = tid & 63, wave = tid >> 6;
  const int stride = gridDim.x * 8;
  for (int rg0 = blockIdx.x * 8 + wave; rg0 < T * 4; rg0 += stride * 4) {
    u32x4 r[4];
#pragma unroll
    for (int k = 0; k < 4; ++k) { const int rg = rg0 + k * stride; const int rgc = (rg < T * 4) ? rg : rg0; r[k] = *(const u32x4*)(P + (size_t)(rgc >> 2) * 5120 + (rgc & 3) * 512 + lane * 8); }
#pragma unroll
    for (int k = 0; k < 4; ++k) {
      const int rg = rg0 + k * stride;
      if (rg < T * 4) {
        const int t = rg >> 2, g = rg & 3;
        float f[8]; unpack8(r[k], f);
        float ss = 0.f;
#pragma unroll
        for (int e = 0; e < 8; ++e) ss += f[e] * f[e];
        ss = wave_sum(ss);
        const float rstd = rsqrtf(ss * (1.f / 512.f) + 1e-5f);
        const f32x4 w0 = *(const f32x4*)(nw + g * 512 + lane * 8), w1 = *(const f32x4*)(nw + g * 512 + lane * 8 + 4);
        f[0] *= rstd * w0[0]; f[1] *= rstd * w0[1]; f[2] *= rstd * w0[2]; f[3] *= rstd * w0[3];
        f[4] *= rstd * w1[0]; f[5] *= rstd * w1[1]; f[6] *= rstd * w1[2]; f[7] *= rstd * w1[3];
        if (!dry) *(u32x4*)(P + (size_t)t * 5120 + g * 512 + lane * 8) = pack8(f);
      }
    }
  }
}


#define XB_TMO      128
#define XB_XCNT(j)  (256  + 64 * (j))
#define XB_XSUB(j)  (1280 + 64 * (j))
#define XB_XGEN(j)  (2304 + 64 * (j))
#define XB_TOP      3328
#define XB_TOPGEN   3392
#define XCD_BAR_WORDS 3456
#define XB_SPIN_CAP (1u << 20)
#define LAS3 __attribute__((address_space(3)))
DI unsigned xb_ld(unsigned* p)              { return __hip_atomic_load(p, __ATOMIC_RELAXED, __HIP_MEMORY_SCOPE_AGENT); }
DI unsigned xb_add(unsigned* p, unsigned v) { return __hip_atomic_fetch_add(p, v, __ATOMIC_RELAXED, __HIP_MEMORY_SCOPE_AGENT); }
DI unsigned xb_xcc_id() { return (unsigned)__builtin_amdgcn_s_getreg((3 << 11) | 20) & 0xFu; }
#define XB_SPIN(cond, bar) do { unsigned _sp = 0; while (cond) { __builtin_amdgcn_s_sleep(1); \
    if ((++_sp & 255u) == 0u) { if (xb_ld(&(bar)[XB_TMO])) break; if (_sp > XB_SPIN_CAP) { atomicAdd(&(bar)[XB_TMO], 1u); break; } } } } while (0)
struct XcdBarrier { unsigned* bar; unsigned x; volatile LAS3 unsigned* st; };
DI XcdBarrier xcd_barrier_post(unsigned* bar, volatile LAS3 unsigned* st) {
  XcdBarrier b; b.bar = bar; b.x = xb_xcc_id(); b.st = st;
  if (threadIdx.x == 0) (void)xb_add(&bar[XB_XCNT(b.x)], 1u);
  return b;
}
DI void xcd_barrier_complete(unsigned* bar, unsigned x, unsigned& nloc, unsigned& nx) {
  const unsigned G = gridDim.x * gridDim.y * gridDim.z;
  unsigned sum, cnt, mine, sp = 0u;
  for (;;) {
    sum = 0u; cnt = 0u; mine = 0u;
#pragma unroll
    for (unsigned j = 0; j < 16; ++j) { const unsigned c = xb_ld(&bar[XB_XCNT(j)]); sum += c; cnt += (c > 0u) ? 1u : 0u; mine = (j == x) ? c : mine; }
    if (sum == G) break;
    __builtin_amdgcn_s_sleep(1);
    if ((++sp & 255u) == 0u) { if (xb_ld(&bar[XB_TMO])) break; if (sp > XB_SPIN_CAP) { atomicAdd(&bar[XB_TMO], 1u); break; } }
  }
  nloc = mine > 0u ? mine : 1u; nx = cnt > 0u ? cnt : 1u;
}
DI void xcd_barrier(const XcdBarrier& b) {
  asm volatile("s_waitcnt vmcnt(0)" ::: "memory");
  __syncthreads();
  if (threadIdx.x == 0) {
    unsigned* bar = b.bar;
    __builtin_amdgcn_s_waitcnt(0);
    unsigned nloc = b.st[0], nx = b.st[1];
    if (nloc == 0u) { xcd_barrier_complete(bar, b.x, nloc, nx); b.st[0] = nloc; b.st[1] = nx; }
    const unsigned old = xb_add(&bar[XB_XSUB(b.x)], 1u);
    const unsigned gen = old / nloc;
    if (old + 1u == (gen + 1u) * nloc) {
      __builtin_amdgcn_fence(__ATOMIC_RELEASE, "agent");
      asm volatile("s_waitcnt vmcnt(0)" ::: "memory");
      const unsigned og = xb_add(&bar[XB_TOP], 1u);
      const unsigned tg = og / nx;
      if (og + 1u == (tg + 1u) * nx) xb_add(&bar[XB_TOPGEN], 1u);
      else XB_SPIN(xb_ld(&bar[XB_TOPGEN]) == tg, bar);
      __builtin_amdgcn_fence(__ATOMIC_ACQUIRE, "agent");
      xb_add(&bar[XB_XGEN(b.x)], 1u);
      asm volatile("s_waitcnt vmcnt(0)" ::: "memory");
    } else {
      XB_SPIN(xb_ld(&bar[XB_XGEN(b.x)]) == gen, bar);
      __builtin_amdgcn_fence(__ATOMIC_ACQUIRE, "agent");
      asm volatile("s_waitcnt vmcnt(0)" ::: "memory");
    }
  }
  __syncthreads();
}

DI int phase_kind(int ph, int& L) {
  if (ph == NPH - 1) { L = 0; return 9; }
  if (ph == 0) { L = 0; return 0; }
  int sub;
  if (ph < 6) { L = 0; sub = ph; } else if (ph < 14) { L = 1; sub = ph - 5; } else if (ph < 19) { L = 2; sub = ph - 13; } else { L = 3; sub = ph - 18; }
  if (L & 1) { return (sub < 3) ? sub : (sub == 3) ? 10 : (sub < 7) ? sub - 1 : sub; }
  return (sub < 3) ? sub : ((sub == 3) ? 5 : sub + 3);
}
DI void run_phase(const Params& p, int ph, char* lds, bool dry) {
  int L;
  const int kind = phase_kind(ph, L);
  if (kind == 9) { final_norm_phase(p.S, p.final_norm_w, p.X); return; }
  const int i = L >> 1;
  const bool odd = L & 1;
  bf16_t* Wb = p.Wb;
  switch (kind) {
#if !defined(ONLY) || ((ONLY >> 0) & 1)
    case 0: {
      convert_mixer(p, 0, lds, 0);
      init_stream_phase(p.x, p.S, p.ssq);
    } break;
#endif
#if !defined(ONLY) || ((ONLY >> 1) & 1)
    case 1: {
      if (!odd) { pg8::EpiBf16 e{p.P, 1280, nullptr, nullptr, p.ssq}; gemm_run(p.S, 1024, Wb + W_IN, 1024, 1280, lds, e); }
      else { pg8::EpiBf16 e{p.P, 5120, p.dt, p.ssd_dt_bias + i * 32, p.ssq}; gemm_run(p.S, 1024, Wb + W_IN, 1024, 5376, lds, e); }
      convert_ffn(p, L, lds, idle_from(odd ? 64 * 21 : 64 * 5));
    } break;
#endif
#if !defined(ONLY) || ((ONLY >> 2) & 1)
    case 2: {
      if (!odd) {
        bf16_t* cat = p.P + (size_t)T * 1280;
        attn_phase(p.P, cat, p.ap_sinks + i * 8, lds);
        pool_phase(p.P, cat, Wb + W_POOL, p.pool_scale + i * 512, lds);
      } else {
        ssd_cb_phase(p.P, p.H, p.H + (size_t)512 * 16384, p.CB, p.dt, p.acs, p.ssd_conv_w + (size_t)i * 4 * 3072, p.ssd_conv_b + i * 3072, p.ssd_A_log + i * 32, lds);
      }
    } break;
#endif
#if !defined(ONLY) || ((ONLY >> 3) & 1)
    case 3: case 10: ssd_scan_phase(p.P, p.H, p.H + (size_t)512 * 16384, p.CB, p.dt, p.acs, p.ssd_conv_w + (size_t)i * 4 * 3072, p.ssd_conv_b + i * 3072, p.ssd_D + i * 32, lds, dry, kind == 10 ? 1 : 0, (float*)(p.bar + XCD_BAR_WORDS)); break;
#endif
#if !defined(ONLY) || ((ONLY >> 4) & 1)
    case 4: gnorm_phase(p.P, p.ssd_norm_w + i * 2048, dry); break;
#endif
#if !defined(ONLY) || ((ONLY >> 5) & 1)
    case 5: case 8: {
      pg8::EpiResid e{(kind == 5 && L == 0) ? p.x : nullptr, p.S, p.ssq, dry};
      const bf16_t* A; int lda, K; const bf16_t* Bt;
      if (kind == 8) { A = p.P; lda = 2816; K = 2816; Bt = Wb + W_DN; }
      else if (!odd) { A = p.P + (size_t)T * 1280; lda = 1024; K = 1024; Bt = Wb + W_OUT; }
      else { A = p.P; lda = 5120; K = 2048; Bt = Wb + W_OUT; }
      gemm_run(A, lda, Bt, K, 1024, lds, e);
    } break;
#endif
#if !defined(ONLY) || ((ONLY >> 7) & 1)
    case 7: { pg8::EpiSwiglu e{p.P, p.ssq}; gemm_run(p.S, 1024, Wb + W_GU, 1024, 5632, lds, e); if (L < 3) convert_mixer(p, L + 1, lds, idle_from(64 * 22)); } break;
#endif
    default: break;
  }
}

__global__ void __launch_bounds__(512) mega(Params p, int ph_lo, int ph_hi) {
  extern __shared__ __attribute__((aligned(16))) char lds[];
  volatile LAS3 unsigned* st = (volatile LAS3 unsigned*)(LAS3 char*)(lds + 144000);
  if (threadIdx.x < 4) st[threadIdx.x] = 0u;
  __syncthreads();
  XcdBarrier xb = xcd_barrier_post(p.bar, st);
  for (int ph = ph_lo; ph < ph_hi; ++ph) {
#ifdef DUPMASK
    { int L2; const int kind2 = phase_kind(ph, L2);
      if ((DUPMASK >> kind2) & 1) { run_phase(p, ph, lds, ph_lo == 0); xcd_barrier(xb); } }
#endif
    run_phase(p, ph, lds, false);
    if (ph + 1 < ph_hi) {
      if (ph_hi > 1000) cg::this_grid().sync();
      xcd_barrier(xb);
    }
  }
}

extern "C" void kernel_launch(void* const* d_in, const int* in_sizes, int n_in, void* d_out, int out_size, void* d_ws, size_t ws_size, hipStream_t stream) {
  Params p{};
  const float** f = (const float**)&p;
  for (int i = 0; i < 20; ++i) f[i] = (const float*)d_in[i];
  p.X = (float*)d_out;
  char* ws = (char*)d_ws;
  size_t off = 0;
  p.Wb = (bf16_t*)(ws + off); off += W_TOTAL * 2;
  p.H = (bf16_t*)(ws + off); off += (size_t)T * 1024 * 2;
  p.P = (bf16_t*)(ws + off); off += (size_t)T * 5120 * 2;
  p.S = (bf16_t*)(ws + off); off += (size_t)T * 1024 * 2;
  p.bar = (unsigned*)(ws + off); off += (size_t)XCD_BAR_WORDS * 4;
  off += (size_t)2 * 128 * 4 * 1024 * 4;
  { char* os = (char*)d_out; size_t oo = 0;
    p.CB = (bf16_t*)(os + oo); oo += (size_t)512 * 16384 * 2;
    p.dt = (float*)(os + oo); oo += (size_t)T * 32 * 4;
    p.acs = (float*)(os + oo); oo += (size_t)T * 32 * 4;
    p.ssq = (float*)(os + oo); oo += (size_t)T * 16 * 4; }
  static int grid = 0;
  if (!grid) {
    (void)hipFuncSetAttribute((const void*)mega, hipFuncAttributeMaxDynamicSharedMemorySize, (int)LDS_BYTES);
    int dev = 0, cus = 0, per_cu = 0;
    (void)hipGetDevice(&dev);
    (void)hipDeviceGetAttribute(&cus, hipDeviceAttributeMultiprocessorCount, dev);
    (void)hipOccupancyMaxActiveBlocksPerMultiprocessor(&per_cu, mega, 512, LDS_BYTES);
    if (per_cu < 1) per_cu = 1;
    grid = cus * per_cu;
    if (off > ws_size) fprintf(stderr, "workspace too small: need %zu have %zu\n", off, ws_size);
  }
  (void)hipMemsetAsync(p.bar, 0, (size_t)XCD_BAR_WORDS * 4, stream);
#if COOP
  int lo = 0, hi = NPH;
  void* args[] = {&p, &lo, &hi};
  hipError_t e = hipLaunchCooperativeKernel((void*)mega, dim3(grid), dim3(512), args, LDS_BYTES, stream);
  if (e != hipSuccess) fprintf(stderr, "cooperative launch failed: %s (grid %d)\n", hipGetErrorString(e), grid);
#else
  for (int ph = 0; ph < NPH; ++ph) hipLaunchKernelGGL(mega, dim3(grid), dim3(512), LDS_BYTES, stream, p, ph, ph + 1);
#endif
}
```

```cpp
#include <hip/hip_runtime.h>
#include <hip/hip_cooperative_groups.h>
#include <cstdio>
namespace cg = cooperative_groups;

#ifndef COOP
#define COOP 1
#endif

typedef unsigned short bf16_t;
typedef short bf16x8 __attribute__((ext_vector_type(8)));
typedef short s16x4 __attribute__((ext_vector_type(4)));
typedef float f32x4 __attribute__((ext_vector_type(4)));
typedef float f32x16 __attribute__((ext_vector_type(16)));
typedef unsigned u32x4 __attribute__((ext_vector_type(4)));
typedef unsigned u32x2 __attribute__((ext_vector_type(2)));
typedef __bf16 bf2_t __attribute__((ext_vector_type(2)));
typedef float f32x2 __attribute__((ext_vector_type(2)));

#define DI __device__ __forceinline__
#define MFMA(a, b, c) __builtin_amdgcn_mfma_f32_32x32x16_bf16((a), (b), (c), 0, 0, 0)

constexpr int T = 16384;
constexpr int SEQ = 8192;
constexpr int NPH = 28;
constexpr size_t LDS_BYTES = 144016;

constexpr size_t W_IN = 0, W_OUT = 5505024, W_GU = 7602176, W_DN = 13369344, W_POOL = 16252928, W_TOTAL = 16318464;

struct Params {
  const float *x, *mix_norm_w, *ap_w_in, *ap_sinks, *pool_w, *pool_scale, *ap_w_out, *ssd_w_in, *ssd_conv_w, *ssd_conv_b,
      *ssd_dt_bias, *ssd_A_log, *ssd_D, *ssd_norm_w, *ssd_w_out, *ffn_norm_w, *w_gate, *w_up, *w_down, *final_norm_w;
  float* X;
  bf16_t *Wb, *H, *P, *CB, *S;
  float *dt, *acs, *ssq;
  unsigned* bar;
};

DI unsigned pk2(float lo, float hi) { f32x2 v = {lo, hi}; bf2_t r = __builtin_convertvector(v, bf2_t); return __builtin_bit_cast(unsigned, r); }
DI float bflo(unsigned u) { return __uint_as_float(u << 16); }
DI float bfhi(unsigned u) { return __uint_as_float(u & 0xffff0000u); }
DI float silu(float x) { return x * __builtin_amdgcn_rcpf(1.f + __expf(-x)); }
DI int crow(int i, int h) { return (i & 3) + 8 * (i >> 2) + 4 * h; }
DI int otid() { int t = threadIdx.x; asm volatile("" : "+v"(t)); return t; }
DI float wave_sum(float v) {
#pragma unroll
  for (int o = 32; o >= 1; o >>= 1) v += __shfl_xor(v, o);
  return v;
}
DI void unpack8(u32x4 r, float (&f)[8]) {
#pragma unroll
  for (int e = 0; e < 4; ++e) { f[2 * e] = bflo(r[e]); f[2 * e + 1] = bfhi(r[e]); }
}
DI u32x4 pack8(const float (&f)[8]) { u32x4 r; r[0] = pk2(f[0], f[1]); r[1] = pk2(f[2], f[3]); r[2] = pk2(f[4], f[5]); r[3] = pk2(f[6], f[7]); return r; }
DI int swz64(int r, int c) { return r * 128 + ((c ^ ((r >> 1) & 7)) << 4); }
DI int swz128(int r, int c) { return r * 256 + ((c ^ (r & 15)) << 4); }

namespace pg8 {
#define PG8_LAS __attribute__((address_space(3)))
constexpr int BM = 256, BK = 64, HALF = 128, HTB = HALF * BK * 2, NXCD = 8, WGM = 8;
DI float row_rstd(const float* ssq, int row) { const f32x4* q = (const f32x4*)(ssq + (size_t)row * 16); const f32x4 a = q[0] + q[1] + q[2] + q[3]; return rsqrtf((a[0] + a[1] + a[2] + a[3]) * (1.f / 1024.f) + 1e-5f); }
DI int lds_byte(int r, int c) { const int st = (r >> 4) * 2 + (c >> 5), rr = r & 15, cc = c & 31, ob = rr * 64 + cc * 2; return st * 1024 + (ob ^ (((ob >> 9) & 1) << 5)); }
DI void stage_rc(int b, int& R, int& C) { const int st = b / 1024, sb = b % 1024, swz = sb ^ (((sb >> 9) & 1) << 5); R = (st >> 1) * 16 + swz / 64; C = (st & 1) * 32 + (swz % 64) / 2; }
DI int perm32(int rho) { const int n = rho >> 4, i = rho & 15; return 8 * (i >> 2) + 4 * n + (i & 3); }
struct Unit { int pm, pn; };
struct Gemm { const bf16_t* A; const bf16_t* Bt; int lda, N, K; };
struct StaticOrder {
  int nM, nN, nwg, G, c;
  DI void init(int M, int N, int G_, int c_) { nM = M / BM; nN = N / BM; nwg = nM * nN; G = G_; c = c_; }
  DI bool next(int i, Unit& u) const {
    const long L = (long)i * G + c; if (L >= nwg) return false;
    int wgid = (int)L; { const int q = nwg / NXCD, r = nwg % NXCD, xcd = wgid % NXCD, off = wgid / NXCD; wgid = (xcd < r ? xcd * (q + 1) : r * (q + 1) + (xcd - r) * q) + off; }
    const int nig = WGM * nN, gid = wgid / nig, fm = gid * WGM, gsz = (nM - fm) < WGM ? (nM - fm) : WGM;
    u.pm = fm + ((wgid % nig) % gsz); u.pn = (wgid % nig) / gsz; return true;
  }
};
struct EpiBf16 {
  static constexpr bool PERM = true, RSTD = true;
  bf16_t* C; int ldc; float* dt; const float* bias; const float* ssq;
  DI void operator()(const f32x4 (&acc)[2][2][4][2], const Unit& u, int wr, int wc, int fr, int fq, const PG8_LAS float* sR) const {
    const int row0 = u.pm * BM + wr * 64 + fr;
    if (dt != nullptr && u.pn == 20) {
      if (wc == 0) {
        const f32x4 b0 = *(const f32x4*)(bias + 8 * fq), b1 = *(const f32x4*)(bias + 8 * fq + 4);
#pragma unroll
        for (int ai = 0; ai < 2; ++ai)
#pragma unroll
          for (int m = 0; m < 4; ++m) {
            f32x4 o0, o1;
            const float rs = sR[ai * 128 + m * 16 + fr];
#pragma unroll
            for (int e = 0; e < 4; ++e) {
              const float v0 = acc[ai][0][m][0][e] * rs + b0[e], v1 = acc[ai][0][m][1][e] * rs + b1[e];
              o0[e] = fmaxf(v0, 0.f) + log1pf(__expf(-fabsf(v0))); o1[e] = fmaxf(v1, 0.f) + log1pf(__expf(-fabsf(v1)));
            }
            float* dp = dt + (size_t)(row0 + ai * HALF + m * 16) * 32 + 8 * fq;
            *(f32x4*)dp = o0; *(f32x4*)(dp + 4) = o1;
          }
      }
      return;
    }
    const int col0 = u.pn * BM + wc * 32 + 8 * fq;
#pragma unroll
    for (int ai = 0; ai < 2; ++ai)
#pragma unroll
      for (int m = 0; m < 4; ++m) {
        bf16_t* rowp = C + (size_t)(row0 + ai * HALF + m * 16) * ldc + col0;
        const float rs = sR[ai * 128 + m * 16 + fr];
#pragma unroll
        for (int bj = 0; bj < 2; ++bj) {
          const f32x4 v0 = acc[ai][bj][m][0] * rs, v1 = acc[ai][bj][m][1] * rs;
          u32x4 w; w[0] = pk2(v0[0], v0[1]); w[1] = pk2(v0[2], v0[3]); w[2] = pk2(v1[0], v1[1]); w[3] = pk2(v1[2], v1[3]);
          *(u32x4*)(rowp + bj * HALF) = w;
        }
      }
  }
};
struct EpiResid {
  static constexpr bool PERM = false, RSTD = false;
  const float* X0; bf16_t* S; float* ssq; bool dry;
  DI void operator()(const f32x4 (&acc)[2][2][4][2], const Unit& u, int wr, int wc, int fr, int fq, const PG8_LAS float* sR) const {
    const int row0 = u.pm * BM + wr * 64 + fr, col0 = u.pn * BM + wc * 32 + 4 * fq;
#pragma unroll
    for (int ai = 0; ai < 2; ++ai) {
      u32x2 sv[4][2][2];
      if (X0 == nullptr) {
#pragma unroll
        for (int m = 0; m < 4; ++m)
#pragma unroll
          for (int bj = 0; bj < 2; ++bj)
#pragma unroll
            for (int n = 0; n < 2; ++n) sv[m][bj][n] = *(const u32x2*)(S + (size_t)(row0 + ai * HALF + m * 16) * 1024 + col0 + bj * HALF + n * 16);
      } else {
#pragma unroll
        for (int m = 0; m < 4; ++m)
#pragma unroll
          for (int bj = 0; bj < 2; ++bj)
#pragma unroll
            for (int n = 0; n < 2; ++n) sv[m][bj][n] = (u32x2){0u, 0u};
      }
#pragma unroll
      for (int m = 0; m < 4; ++m) {
        const int row = row0 + ai * HALF + m * 16;
        const size_t ro = (size_t)row * 1024 + col0;
        float ss = 0.f;
#pragma unroll
        for (int bj = 0; bj < 2; ++bj)
#pragma unroll
          for (int n = 0; n < 2; ++n) {
            f32x4 v;
            if (X0 != nullptr) v = *(const f32x4*)(X0 + ro + bj * HALF + n * 16);
            else { const u32x2 q = sv[m][bj][n]; v[0] = bflo(q[0]); v[1] = bfhi(q[0]); v[2] = bflo(q[1]); v[3] = bfhi(q[1]); }
            v += acc[ai][bj][m][n];
            ss += v[0] * v[0] + v[1] * v[1] + v[2] * v[2] + v[3] * v[3];
            if (!dry) { u32x2 q; q[0] = pk2(v[0], v[1]); q[1] = pk2(v[2], v[3]); *(u32x2*)(S + ro + bj * HALF + n * 16) = q; }
          }
        ss += __shfl_xor(ss, 16); ss += __shfl_xor(ss, 32);
        if (!dry && fq == 0) ssq[(size_t)row * 16 + u.pn * 4 + wc] = ss;
      }
    }
  }
};
struct EpiSwiglu {
  static constexpr bool PERM = false, RSTD = true;
  bf16_t* Hd; const float* ssq;
  DI void operator()(const f32x4 (&acc)[2][2][4][2], const Unit& u, int wr, int wc, int fr, int fq, const PG8_LAS float* sR) const {
    const int row0 = u.pm * BM + wr * 64 + fr, j0 = (u.pn * BM + wc * 32) / 2 + 4 * fq;
#pragma unroll
    for (int ai = 0; ai < 2; ++ai)
#pragma unroll
      for (int m = 0; m < 4; ++m) {
        bf16_t* rowp = Hd + (size_t)(row0 + ai * HALF + m * 16) * 2816 + j0;
        const float rs = sR[ai * 128 + m * 16 + fr];
#pragma unroll
        for (int bj = 0; bj < 2; ++bj) {
          const f32x4 g = acc[ai][bj][m][0] * rs, up = acc[ai][bj][m][1] * rs;
          u32x2 o; o[0] = pk2(silu(g[0]) * up[0], silu(g[1]) * up[1]); o[1] = pk2(silu(g[2]) * up[2], silu(g[3]) * up[3]);
          *(u32x2*)(rowp + bj * (HALF / 2)) = o;
        }
      }
  }
};

template <class Epi>
DI void gemm_phase(PG8_LAS unsigned char* lds, const Gemm g, const StaticOrder& S, const Epi& E) {
  const int tid = otid(), wid = __builtin_amdgcn_readfirstlane(tid >> 6), lane = tid & 63, wr = wid >> 2, wc = wid & 3, fr = lane & 15, fq = lane >> 4;
  const int K = g.K, nt = K / BK;
  unsigned voffA[2], voffB[2];
#pragma unroll
  for (int i = 0; i < 2; ++i) { int R, C; stage_rc(tid * 16 + i * 8192, R, C); const int Rb = Epi::PERM ? ((R & ~31) + perm32(R & 31)) : R;
    voffA[i] = (unsigned)(R * g.lda + C) * 2u; voffB[i] = (unsigned)(Rb * K + C) * 2u; }
  const size_t kstep = (size_t)(BK * 2);
  const size_t hstepA = (size_t)HALF * g.lda * 2, hstepB = (size_t)HALF * K * 2;
  const size_t tstepA = 2 * hstepA, tstepB = 2 * hstepB;
  const unsigned ldsw = (unsigned)wid * 1024u;
  const int aoff = lds_byte(wr * 64 + fr, fq * 8), boff = lds_byte(wc * 32 + fr, fq * 8);
#define PG8_SA(b, h) (((b) * 2 + (h)) * HTB)
#define PG8_SB(b, h) ((4 + (b) * 2 + (h)) * HTB)
#define PG8_STAGE(bufoff, gbase, voff) do { _Pragma("unroll") for (int _i = 0; _i < 2; ++_i) \
    __builtin_amdgcn_global_load_lds((const unsigned*)((const char*)(gbase) + (voff)[_i]), (PG8_LAS unsigned*)(lds + (bufoff) + ldsw + _i * 8192), 16, 0, 0); } while (0)
#define PG8_LDA(dst, b, h) do { _Pragma("unroll") for (int m = 0; m < 4; ++m) _Pragma("unroll") for (int k = 0; k < 2; ++k) dst[m][k] = *(const PG8_LAS bf16x8*)(lds + PG8_SA(b, h) + aoff + m * 2048 + k * 1024); } while (0)
#define PG8_LDB(dst, b, h) do { _Pragma("unroll") for (int n = 0; n < 2; ++n) _Pragma("unroll") for (int k = 0; k < 2; ++k) dst[n][k] = *(const PG8_LAS bf16x8*)(lds + PG8_SB(b, h) + boff + n * 2048 + k * 1024); } while (0)
#define PG8_MMA(ai, bj, At, Bt) do { __builtin_amdgcn_s_setprio(1); _Pragma("unroll") for (int m = 0; m < 4; ++m) _Pragma("unroll") for (int n = 0; n < 2; ++n) _Pragma("unroll") for (int k = 0; k < 2; ++k) \
    acc[ai][bj][m][n] = __builtin_amdgcn_mfma_f32_16x16x32_bf16(Bt[n][k], At[m][k], acc[ai][bj][m][n], 0, 0, 0); __builtin_amdgcn_s_setprio(0); } while (0)
#define PG8_WAIT_V(n) asm volatile("s_waitcnt vmcnt(" #n ")" ::: "memory")
#define PG8_WAIT_L(n) asm volatile("s_waitcnt lgkmcnt(" #n ")" ::: "memory")
#define PG8_BAR __builtin_amdgcn_s_barrier()
#define PG8_SCHED __builtin_amdgcn_sched_barrier(0)
  Unit cur, nxt; int ui = 0;
  if (!S.next(0, cur)) return;
  f32x4 acc[2][2][4][2];
#pragma unroll
  for (int a = 0; a < 2; ++a)
#pragma unroll
    for (int b = 0; b < 2; ++b)
#pragma unroll
      for (int m = 0; m < 4; ++m)
#pragma unroll
        for (int n = 0; n < 2; ++n) acc[a][b][m][n] = (f32x4){0.f, 0.f, 0.f, 0.f};
  bf16x8 At[4][2], B0[2][2], B1[2][2];
  const char* cA = (const char*)g.A + (size_t)cur.pm * tstepA; const char* cB = (const char*)g.Bt + (size_t)cur.pn * tstepB;
  PG8_STAGE(PG8_SB(0, 0), cB, voffB); PG8_STAGE(PG8_SA(0, 0), cA, voffA); PG8_STAGE(PG8_SB(0, 1), cB + hstepB, voffB); PG8_STAGE(PG8_SA(0, 1), cA + hstepA, voffA);
  if (wr == 1) PG8_BAR;
  PG8_WAIT_V(4); PG8_BAR;
  PG8_STAGE(PG8_SB(1, 0), cB + kstep, voffB); PG8_STAGE(PG8_SA(1, 0), cA + kstep, voffA); PG8_STAGE(PG8_SB(1, 1), cB + hstepB + kstep, voffB);
  PG8_WAIT_V(6); PG8_BAR;
  for (;;) {
    const bool has_next = S.next(ui + 1, nxt);
    const char* nA = has_next ? (const char*)g.A + (size_t)nxt.pm * tstepA : cA; const char* nB = has_next ? (const char*)g.Bt + (size_t)nxt.pn * tstepB : cB;
    for (int t = 0; t < nt; t += 2) {
      const bool last = (t == nt - 2);
      const char* a1 = cA + (size_t)(t + 1) * kstep;
      const char* a2 = last ? nA : cA + (size_t)(t + 2) * kstep; const char* b2 = last ? nB : cB + (size_t)(t + 2) * kstep;
      const char* a3 = a2 + kstep; const char* b3 = b2 + kstep;
      PG8_LDB(B0, 0, 0); PG8_SCHED; PG8_LDA(At, 0, 0); PG8_STAGE(PG8_SA(1, 1), a1 + hstepA, voffA);
      PG8_WAIT_L(8); PG8_BAR; PG8_WAIT_L(0); PG8_MMA(0, 0, At, B0); PG8_BAR; PG8_SCHED;
      PG8_LDB(B1, 0, 1); PG8_STAGE(PG8_SB(0, 0), b2, voffB);
      PG8_BAR; PG8_WAIT_L(0); PG8_MMA(0, 1, At, B1); PG8_BAR;
      PG8_LDA(At, 0, 1); PG8_STAGE(PG8_SA(0, 0), a2, voffA);
      PG8_BAR; PG8_WAIT_L(0); PG8_MMA(1, 0, At, B0); PG8_BAR; PG8_SCHED;
      PG8_STAGE(PG8_SB(0, 1), b2 + hstepB, voffB);
      PG8_WAIT_V(6); PG8_BAR; PG8_MMA(1, 1, At, B1); PG8_BAR;
      PG8_LDB(B0, 1, 0); PG8_SCHED; PG8_LDA(At, 1, 0); PG8_STAGE(PG8_SA(0, 1), a2 + hstepA, voffA);
      PG8_WAIT_L(8); PG8_BAR; PG8_WAIT_L(0); PG8_MMA(0, 0, At, B0); PG8_BAR; PG8_SCHED;
      PG8_LDB(B1, 1, 1); PG8_STAGE(PG8_SB(1, 0), b3, voffB);
      PG8_BAR; PG8_WAIT_L(0); PG8_MMA(0, 1, At, B1); PG8_BAR;
      PG8_LDA(At, 1, 1); PG8_STAGE(PG8_SA(1, 0), a3, voffA);
      PG8_BAR; PG8_WAIT_L(0); PG8_MMA(1, 0, At, B0); PG8_BAR; PG8_SCHED;
      PG8_STAGE(PG8_SB(1, 1), b3 + hstepB, voffB);
      PG8_WAIT_V(6); PG8_BAR; PG8_MMA(1, 1, At, B1); PG8_BAR;
    }
    const PG8_LAS float* sR = (const PG8_LAS float*)(lds + 131072) + ui * 256 + wr * 64;
    E(acc, cur, wr, wc, fr, fq, sR);
    if (!has_next) break;
#pragma unroll
    for (int a = 0; a < 2; ++a)
#pragma unroll
      for (int b = 0; b < 2; ++b)
#pragma unroll
        for (int m = 0; m < 4; ++m)
#pragma unroll
          for (int n = 0; n < 2; ++n) acc[a][b][m][n] = (f32x4){0.f, 0.f, 0.f, 0.f};
    cur = nxt; cA = nA; cB = nB; ++ui;
  }
  PG8_WAIT_V(0);
  if (wr == 0) PG8_BAR;
  PG8_BAR;
#undef PG8_SA
#undef PG8_SB
#undef PG8_STAGE
#undef PG8_LDA
#undef PG8_LDB
#undef PG8_MMA
#undef PG8_WAIT_V
#undef PG8_WAIT_L
#undef PG8_BAR
#undef PG8_SCHED
}
}

template <class Epi>
DI void gemm_run(const bf16_t* A, int lda, const bf16_t* Bt, int K, int N, char* lds, const Epi& e) {
  pg8::Gemm g{A, Bt, lda, N, K};
  pg8::StaticOrder S; S.init(T, N, (int)gridDim.x, (int)blockIdx.x);
  if constexpr (Epi::RSTD) {
    __attribute__((address_space(3))) float* sRall = (__attribute__((address_space(3))) float*)(lds + 131072);
    pg8::Unit u;
    const int tq = otid();
    for (int i = tq >> 8; S.next(i, u); i += 2) sRall[i * 256 + (tq & 255)] = pg8::row_rstd(e.ssq, u.pm * 256 + (tq & 255));
  }
  __syncthreads();
  pg8::gemm_phase(( __attribute__((address_space(3))) unsigned char*)lds, g, S, e);
  __syncthreads();
}

DI void init_stream_phase(const float* Xin, bf16_t* S, float* ssq) {
  const int tid = otid(), lane = tid & 63, wave = tid >> 6;
  const int stride = gridDim.x * 8;
  for (int row0 = blockIdx.x * 8 + wave; row0 < T; row0 += stride * 2) {
    f32x4 v[2][4];
#pragma unroll
    for (int k = 0; k < 2; ++k) { const int row = (row0 + k * stride < T) ? row0 + k * stride : row0; const f32x4* xr = (const f32x4*)(Xin + (size_t)row * 1024);
#pragma unroll
      for (int j = 0; j < 4; ++j) v[k][j] = xr[lane + 64 * j]; }
#pragma unroll
    for (int k = 0; k < 2; ++k) {
      const int row = row0 + k * stride;
      if (row < T) {
        float ss = 0.f;
#pragma unroll
        for (int j = 0; j < 4; ++j) ss += v[k][j][0] * v[k][j][0] + v[k][j][1] * v[k][j][1] + v[k][j][2] * v[k][j][2] + v[k][j][3] * v[k][j][3];
        ss = wave_sum(ss);
#pragma unroll
        for (int j = 0; j < 4; ++j) { u32x2 q; q[0] = pk2(v[k][j][0], v[k][j][1]); q[1] = pk2(v[k][j][2], v[k][j][3]); *(u32x2*)(S + (size_t)row * 1024 + 4 * (lane + 64 * j)) = q; }
        if (lane < 16) ssq[(size_t)row * 16 + lane] = (lane == 0) ? ss : 0.f;
      }
    }
  }
}
DI void final_norm_phase(const bf16_t* S, const float* w, float* out) {
  const int tid = otid(), lane = tid & 63, wave = tid >> 6;
  const int stride = gridDim.x * 8;
  f32x4 wv[4];
#pragma unroll
  for (int q = 0; q < 4; ++q) wv[q] = *(const f32x4*)(w + (q >> 1) * 512 + lane * 8 + (q & 1) * 4);
  for (int row0 = blockIdx.x * 8 + wave; row0 < T; row0 += stride * 4) {
    u32x4 r[4][2];
#pragma unroll
    for (int k = 0; k < 4; ++k) { const int row = (row0 + k * stride < T) ? row0 + k * stride : row0;
      r[k][0] = *(const u32x4*)(S + (size_t)row * 1024 + lane * 8); r[k][1] = *(const u32x4*)(S + (size_t)row * 1024 + 512 + lane * 8); }
#pragma unroll
    for (int k = 0; k < 4; ++k) {
      const int row = row0 + k * stride;
      if (row < T) {
        float f[16];
        { float a[8], b2[8]; unpack8(r[k][0], a); unpack8(r[k][1], b2);
#pragma unroll
          for (int e = 0; e < 8; ++e) { f[e] = a[e]; f[8 + e] = b2[e]; } }
        float ss = 0.f;
#pragma unroll
        for (int e = 0; e < 16; ++e) ss += f[e] * f[e];
        ss = wave_sum(ss);
        const float rstd = rsqrtf(ss * (1.f / 1024.f) + 1e-5f);
#pragma unroll
        for (int hlf = 0; hlf < 2; ++hlf) {
          const int c0 = hlf * 512 + lane * 8;
          f32x4 o0, o1;
#pragma unroll
          for (int e = 0; e < 4; ++e) { o0[e] = f[hlf * 8 + e] * rstd * wv[2 * hlf][e]; o1[e] = f[hlf * 8 + 4 + e] * rstd * wv[2 * hlf + 1][e]; }
          *(f32x4*)(out + (size_t)row * 1024 + c0) = o0; *(f32x4*)(out + (size_t)row * 1024 + c0 + 4) = o1;
        }
      }
    }
  }
}

#define LDS_BARRIER() do { asm volatile("s_waitcnt lgkmcnt(0)" ::: "memory"); __builtin_amdgcn_s_barrier(); asm volatile("" ::: "memory"); } while (0)
struct CvtJob { const float* src; bf16_t* dst; const float* kscale; int K, N, Npad, mode, ntiles; };
DI CvtJob cvt_job(const float* src, int K, int N, bf16_t* dst, int Npad, int mode, const float* kscale) {
  CvtJob j; j.src = src; j.dst = dst; j.kscale = kscale; j.K = K; j.N = N; j.Npad = Npad; j.mode = mode; j.ntiles = (K >> 6) * ((Npad + 255) >> 8); return j;
}
DI void convert_tile(const CvtJob& jb, int ti, char* lds) {
  float* tile = (float*)lds;
  const int tid = otid();
  const int K = jb.K, N = jb.N;
  const int nkt = K >> 6;
  const int kt = ti % nkt, nt = ti / nkt, k0 = kt * 64, n0 = nt * 256;
  const int nn = tid & 255, kr = tid >> 8;
  const int n = n0 + nn;
  float v[32];
#pragma unroll
  for (int i = 0; i < 32; ++i) v[i] = (n < N) ? jb.src[(size_t)(k0 + kr + 2 * i) * N + n] : 0.f;
#pragma unroll
  for (int i = 0; i < 32; ++i) { const int k = kr + 2 * i; tile[k * 257 + nn] = jb.kscale ? v[i] * jb.kscale[k0 + k] : v[i]; }
  __syncthreads();
#pragma unroll
  for (int j = 0; j < 4; ++j) {
    const int q = tid + 512 * j, nw = q >> 3, kc = q & 7;
    float f[8];
#pragma unroll
    for (int e = 0; e < 8; ++e) f[e] = tile[(kc * 8 + e) * 257 + nw];
    const int nr = n0 + nw;
    if (nr < jb.Npad) {
      const int drow = (jb.mode == 0) ? nr : (32 * (nr >> 4) + (nr & 15) + (jb.mode == 2 ? 16 : 0));
      *(u32x4*)(jb.dst + (size_t)drow * K + k0 + kc * 8) = pack8(f);
    }
  }
  LDS_BARRIER();
}
template <int NJ>
DI void convert_jobs(const CvtJob (&jobs)[NJ], char* lds, int first_blk) {
  if ((int)blockIdx.x < first_blk) return;
  int total = 0;
#pragma unroll
  for (int j = 0; j < NJ; ++j) total += jobs[j].ntiles;
  for (int ti = (int)blockIdx.x - first_blk; ti < total; ti += (int)gridDim.x - first_blk) {
    int rem = ti; bool done = false;
#pragma unroll
    for (int j = 0; j < NJ; ++j) {
      if (!done) { if (rem < jobs[j].ntiles) { convert_tile(jobs[j], rem, lds); done = true; } else rem -= jobs[j].ntiles; }
    }
  }
}
DI void convert_ffn(const Params& p, int L, char* lds, int first_blk) {
  const float* nw2 = p.ffn_norm_w + L * 1024;
  const CvtJob jobs[3] = {
    cvt_job(p.w_gate + (size_t)L * 1024 * 2816, 1024, 2816, p.Wb + W_GU, 2816, 1, nw2), cvt_job(p.w_up + (size_t)L * 1024 * 2816, 1024, 2816, p.Wb + W_GU, 2816, 2, nw2),
    cvt_job(p.w_down + (size_t)L * 2816 * 1024, 2816, 1024, p.Wb + W_DN, 1024, 0, nullptr)};
  convert_jobs(jobs, lds, first_blk);
}
DI void convert_mixer(const Params& p, int L, char* lds, int first_blk) {
  const int i = L >> 1; bf16_t* Wb = p.Wb;
  const float* nw1 = p.mix_norm_w + L * 1024;
  if (!(L & 1)) {
    const CvtJob jobs[6] = {
      cvt_job(p.ap_w_in + (size_t)i * 1024 * 1280, 1024, 1280, Wb + W_IN, 1280, 0, nw1), cvt_job(p.ap_w_out + (size_t)i * 1024 * 1024, 1024, 1024, Wb + W_OUT, 1024, 0, nullptr),
      cvt_job(p.pool_w + (size_t)(i * 4 + 0) * 16384, 128, 128, Wb + W_POOL, 128, 0, nullptr), cvt_job(p.pool_w + (size_t)(i * 4 + 1) * 16384, 128, 128, Wb + W_POOL + 16384, 128, 0, nullptr),
      cvt_job(p.pool_w + (size_t)(i * 4 + 2) * 16384, 128, 128, Wb + W_POOL + 32768, 128, 0, nullptr), cvt_job(p.pool_w + (size_t)(i * 4 + 3) * 16384, 128, 128, Wb + W_POOL + 49152, 128, 0, nullptr)};
    convert_jobs(jobs, lds, first_blk);
  } else {
    const CvtJob jobs[2] = {
      cvt_job(p.ssd_w_in + (size_t)i * 1024 * 5152, 1024, 5152, Wb + W_IN, 5376, 0, nw1), cvt_job(p.ssd_w_out + (size_t)i * 2048 * 1024, 2048, 1024, Wb + W_OUT, 1024, 0, nullptr)};
    convert_jobs(jobs, lds, first_blk);
  }
}
DI int idle_from(int nunits) { const int r = nunits % (int)gridDim.x; return r; }

DI void attn_phase(const bf16_t* proj, bf16_t* cat, const float* sinks, char* lds) {
  char* sK = lds; char* sVt = lds + 32768;
  const int tid = otid(), lane = tid & 63, wave = tid >> 6, h = lane >> 5, l31 = lane & 31;
  const int swz = (lane >> 1) & 7;
  for (int item = blockIdx.x; item < 256; item += gridDim.x) {
    const int kvh = item & 1, nb = (item >> 1) & 63, b = item >> 7;
    const int tok0 = b * SEQ + nb * 128;
    u32x4 kv[8];
#pragma unroll
    for (int j = 0; j < 4; ++j) {
      const int q = tid + 512 * j;
      { const int key = q >> 3, c = q & 7; const bool ok = (nb > 0 || key >= 128);
        kv[j] = *(const u32x4*)(proj + (size_t)(ok ? (tok0 - 128 + key) : tok0) * 1280 + 512 + kvh * 64 + c * 8); }
      { const int key = q & 255, c = q >> 8; const bool ok = (nb > 0 || key >= 128);
        kv[4 + j] = *(const u32x4*)(proj + (size_t)(ok ? (tok0 - 128 + key) : tok0) * 1280 + 640 + kvh * 64 + c * 8); }
    }
#pragma unroll
    for (int j = 0; j < 4; ++j) {
      const int q = tid + 512 * j, key = q >> 3, c = q & 7;
      u32x4 v = kv[j];
      if (!(nb > 0 || key >= 128)) v = (u32x4){0u, 0u, 0u, 0u};
      *(u32x4*)(sK + swz64(key, c)) = v;
    }
#pragma unroll
    for (int j = 0; j < 4; ++j) {
      const int q = tid + 512 * j, key = q & 255, c = q >> 8;
      u32x4 v = kv[4 + j];
      if (!(nb > 0 || key >= 128)) v = (u32x4){0u, 0u, 0u, 0u};
#pragma unroll
      for (int e = 0; e < 8; ++e) *(bf16_t*)(sVt + (c * 8 + e) * 520 + key * 2) = (bf16_t)(v[e >> 1] >> (16 * (e & 1)));
    }
    __syncthreads();
#pragma unroll 1
    for (int task = 0; task < 2; ++task) {
      const int g = wave >> 1, sb = (wave & 1) * 2 + task, head = kvh * 4 + g, q0 = sb * 32;
      const int qi = q0 + l31;
      const size_t qtok = (size_t)tok0 + qi;
      bf16x8 qf[4];
#pragma unroll
      for (int kk = 0; kk < 4; ++kk) qf[kk] = *(const bf16x8*)(proj + qtok * 1280 + head * 64 + kk * 16 + 8 * h);
      f32x16 s[5];
#pragma unroll
      for (int t = 0; t < 5; ++t) {
#pragma unroll
        for (int i = 0; i < 16; ++i) s[t][i] = 0.f;
        const char* kp = sK + (32 * (sb + t) + l31) * 128;
#pragma unroll
        for (int kk = 0; kk < 4; ++kk) { const bf16x8 kf = *(const bf16x8*)(kp + (((kk * 2 + h) ^ swz) << 4)); s[t] = MFMA(kf, qf[kk], s[t]); }
      }
      const float sink = sinks[head];
      float mx = sink;
#pragma unroll
      for (int t = 0; t < 5; ++t)
#pragma unroll
        for (int i = 0; i < 16; ++i) {
          const float pen = (nb > 0 || sb + t >= 4) ? 0.f : -1e30f;
          float sv = s[t][i] * 0.125f + pen;
          if (t == 0) sv = (crow(i, h) > l31) ? sv : -1e30f;
          if (t == 4) sv = (crow(i, h) <= l31) ? sv : -1e30f;
          s[t][i] = sv; mx = fmaxf(mx, sv);
        }
      mx = fmaxf(mx, __shfl_xor(mx, 32));
      float sum = 0.f;
#pragma unroll
      for (int t = 0; t < 5; ++t)
#pragma unroll
        for (int i = 0; i < 16; ++i) { const float pv = __expf(s[t][i] - mx); s[t][i] = pv; sum += pv; }
      sum += __shfl_xor(sum, 32);
      sum += __expf(sink - mx);
      f32x16 o[2];
#pragma unroll
      for (int mi = 0; mi < 2; ++mi)
#pragma unroll
        for (int i = 0; i < 16; ++i) o[mi][i] = 0.f;
#pragma unroll
      for (int t = 0; t < 5; ++t)
#pragma unroll
        for (int s2 = 0; s2 < 2; ++s2) {
          u32x4 pp;
#pragma unroll
          for (int e = 0; e < 4; ++e) pp[e] = pk2(s[t][8 * s2 + 2 * e], s[t][8 * s2 + 2 * e + 1]);
          const bf16x8 pf = __builtin_bit_cast(bf16x8, pp);
#pragma unroll
          for (int mi = 0; mi < 2; ++mi) {
            const char* vp = sVt + (mi * 32 + l31) * 520 + (32 * (sb + t) + 16 * s2 + 4 * h) * 2;
            const s16x4 lo = *(const s16x4*)vp; const s16x4 hi = *(const s16x4*)(vp + 16);
            const bf16x8 vf = __builtin_shufflevector(lo, hi, 0, 1, 2, 3, 4, 5, 6, 7);
            o[mi] = MFMA(vf, pf, o[mi]);
          }
        }
      const float inv = 1.f / sum;
#pragma unroll
      for (int mi = 0; mi < 2; ++mi)
#pragma unroll
        for (int gi = 0; gi < 4; ++gi) {
          u32x2 ov; ov[0] = pk2(o[mi][4 * gi] * inv, o[mi][4 * gi + 1] * inv); ov[1] = pk2(o[mi][4 * gi + 2] * inv, o[mi][4 * gi + 3] * inv);
          *(u32x2*)(cat + qtok * 1024 + head * 64 + mi * 32 + 8 * gi + 4 * h) = ov;
        }
    }
    __syncthreads();
  }
}

template <int W, int UB>
DI void pool_fill(const bf16_t* proj, const bf16_t* Wp, char* sD, char* sW, int tid, int t0, int tin0, int g) {
#pragma unroll 1
  for (int jb = 0; jb < 4; jb += UB) {
    u32x4 cu[UB], rr[UB][W - 1], wv[UB];
#pragma unroll
    for (int u = 0; u < UB; ++u) {
      const int q = tid + 512 * (jb + u), tok = q >> 4, c = q & 15, tin = tin0 + tok;
      const bf16_t* pp = proj + (size_t)(t0 + tok) * 1280 + 768 + g * 128 + c * 8;
      cu[u] = *(const u32x4*)pp;
#pragma unroll
      for (int i = 1; i < W; ++i) rr[u][i - 1] = *(const u32x4*)(pp - (size_t)((i <= tin) ? i : 0) * 1280);
      wv[u] = *(const u32x4*)(Wp + (size_t)g * 16384 + tok * 128 + c * 8);
    }
#pragma unroll
    for (int u = 0; u < UB; ++u) {
      const int q = tid + 512 * (jb + u), tok = q >> 4, c = q & 15, tin = tin0 + tok;
      float cur[8], sum[8], d[8];
      unpack8(cu[u], cur);
#pragma unroll
      for (int e = 0; e < 8; ++e) sum[e] = cur[e];
#pragma unroll
      for (int i = 1; i < W; ++i) {
        float f[8]; unpack8(rr[u][i - 1], f);
        const float m = (i <= tin) ? 1.f : 0.f;
#pragma unroll
        for (int e = 0; e < 8; ++e) sum[e] += m * f[e];
      }
      const int cnt = (tin + 1 < W) ? (tin + 1) : W;
      const float ic = 1.f / (float)cnt;
#pragma unroll
      for (int e = 0; e < 8; ++e) d[e] = sum[e] * ic - cur[e];
      *(u32x4*)(sD + swz128(tok, c)) = pack8(d);
      *(u32x4*)(sW + swz128(tok, c)) = wv[u];
    }
  }
}
DI void pool_phase(const bf16_t* proj, bf16_t* cat, const bf16_t* Wp, const float* scale, char* lds) {
  char* sD = lds; char* sW = lds + 32768;
  const int tid = otid(), lane = tid & 63, wave = tid >> 6, h = lane >> 5, l31 = lane & 31;
  for (int item = blockIdx.x; item < 512; item += gridDim.x) {
    const int g = item & 3, tt = item >> 2, t0 = tt * 128, tin0 = t0 & (SEQ - 1);
    if (g == 0) pool_fill<2, 4>(proj, Wp, sD, sW, tid, t0, tin0, g); else if (g == 1) pool_fill<4, 4>(proj, Wp, sD, sW, tid, t0, tin0, g);
    else if (g == 2) pool_fill<8, 2>(proj, Wp, sD, sW, tid, t0, tin0, g); else pool_fill<16, 1>(proj, Wp, sD, sW, tid, t0, tin0, g);
    __syncthreads();
    const int tk = wave & 3, dt0 = (wave >> 2) * 2;
    f32x16 acc[2];
#pragma unroll
    for (int e = 0; e < 2; ++e)
#pragma unroll
      for (int i = 0; i < 16; ++i) acc[e][i] = 0.f;
#pragma unroll
    for (int kk = 0; kk < 8; ++kk) {
      const bf16x8 yf = *(const bf16x8*)(sD + swz128(32 * tk + l31, 2 * kk + h));
#pragma unroll
      for (int e = 0; e < 2; ++e) {
        const bf16x8 xf = *(const bf16x8*)(sW + swz128(32 * (dt0 + e) + l31, 2 * kk + h));
        acc[e] = MFMA(xf, yf, acc[e]);
      }
    }
    const size_t tok = (size_t)t0 + 32 * tk + l31;
#pragma unroll
    for (int e = 0; e < 2; ++e)
#pragma unroll
      for (int gi = 0; gi < 4; ++gi) {
        const int dout = 32 * (dt0 + e) + 8 * gi + 4 * h;
        const f32x4 sc = *(const f32x4*)(scale + g * 128 + dout);
        u32x2 ov; ov[0] = pk2(acc[e][4 * gi] * sc[0], acc[e][4 * gi + 1] * sc[1]); ov[1] = pk2(acc[e][4 * gi + 2] * sc[2], acc[e][4 * gi + 3] * sc[3]);
        *(u32x2*)(cat + tok * 1024 + 512 + g * 128 + dout) = ov;
      }
    LDS_BARRIER();
  }
}

DI void conv8(const bf16_t* P, size_t tok, int tin, int col, const float* cw, const float* cb, float (&out)[8]) {
  float a[8];
  { const f32x4 b0 = *(const f32x4*)(cb + col), b1 = *(const f32x4*)(cb + col + 4);
    a[0] = b0[0]; a[1] = b0[1]; a[2] = b0[2]; a[3] = b0[3]; a[4] = b1[0]; a[5] = b1[1]; a[6] = b1[2]; a[7] = b1[3]; }
  u32x4 raw[4];
#pragma unroll
  for (int kk = 0; kk < 4; ++kk) raw[kk] = *(const u32x4*)(P + (tok - ((tin - 3 + kk >= 0) ? (3 - kk) : 0)) * 5120 + 2048 + col);
#pragma unroll
  for (int kk = 0; kk < 4; ++kk) {
    float f[8]; unpack8(raw[kk], f);
    const float ok = (tin - 3 + kk >= 0) ? 1.f : 0.f;
    const f32x4 w0 = *(const f32x4*)(cw + kk * 3072 + col) * ok, w1 = *(const f32x4*)(cw + kk * 3072 + col + 4) * ok;
    a[0] += w0[0] * f[0]; a[1] += w0[1] * f[1]; a[2] += w0[2] * f[2]; a[3] += w0[3] * f[3];
    a[4] += w1[0] * f[4]; a[5] += w1[1] * f[5]; a[6] += w1[2] * f[6]; a[7] += w1[3] * f[7];
  }
#pragma unroll
  for (int e = 0; e < 8; ++e) out[e] = silu(a[e]);
}

DI void ssd_cb_phase(const bf16_t* P, bf16_t* BT, bf16_t* Cc, bf16_t* CB, const float* dt, float* acs,
                     const float* cw, const float* cb, const float* A_log, char* lds) {
  char* sB = lds; char* sC = lds + 32768;
  const int tid = otid(), lane = tid & 63, wave = tid >> 6, h = lane >> 5, l31 = lane & 31;
  for (int item = blockIdx.x; item < 512; item += gridDim.x) {
    const int g = item & 3, c = (item >> 2) & 63, b = item >> 8;
    const size_t t0 = (size_t)b * SEQ + c * 128;
    const int tin0 = c * 128;
    bf16_t* BTi = BT + (size_t)item * 16384; bf16_t* Cci = Cc + (size_t)item * 16384; bf16_t* CBi = CB + (size_t)item * 16384;
    float* sW = (float*)(lds + 65536);
    u32x4 raw[4][4];
#pragma unroll
    for (int j = 0; j < 4; ++j) {
      const int q = tid + 512 * j;
      const int lb = q & 127, cb8 = q >> 7;
#pragma unroll
      for (int kk = 0; kk < 4; ++kk) raw[j][kk] = *(const u32x4*)(P + (t0 + lb - ((tin0 + lb - 3 + kk >= 0) ? (3 - kk) : 0)) * 5120 + 2048 + 2048 + g * 128 + cb8 * 8);
    }
    for (int q = tid; q < 1280; q += 512) { const int which = q / 640, r = q % 640, kk = r >> 7, col = 2048 + which * 512 + g * 128 + (r & 127); sW[q] = (kk < 4) ? cw[kk * 3072 + col] : cb[col]; }
    LDS_BARRIER();
#pragma unroll
    for (int j = 0; j < 4; ++j) {
      const int q = tid + 512 * j, l = q & 127, cch = q >> 7;
      float v[8];
      { const f32x4 b0 = *(const f32x4*)(sW + 512 + cch * 8), b1 = *(const f32x4*)(sW + 512 + cch * 8 + 4);
        v[0] = b0[0]; v[1] = b0[1]; v[2] = b0[2]; v[3] = b0[3]; v[4] = b1[0]; v[5] = b1[1]; v[6] = b1[2]; v[7] = b1[3]; }
#pragma unroll
      for (int kk = 0; kk < 4; ++kk) {
        float f[8]; unpack8(raw[j][kk], f);
        const float ok = (tin0 + l - 3 + kk >= 0) ? 1.f : 0.f;
        const f32x4 w0 = *(const f32x4*)(sW + kk * 128 + cch * 8) * ok, w1 = *(const f32x4*)(sW + kk * 128 + cch * 8 + 4) * ok;
        v[0] += w0[0] * f[0]; v[1] += w0[1] * f[1]; v[2] += w0[2] * f[2]; v[3] += w0[3] * f[3];
        v[4] += w1[0] * f[4]; v[5] += w1[1] * f[5]; v[6] += w1[2] * f[6]; v[7] += w1[3] * f[7];
      }
#pragma unroll
      for (int e = 0; e < 8; ++e) v[e] = silu(v[e]);
      const u32x4 pk = pack8(v);
      *(u32x4*)(sB + swz128(l, cch)) = pk;
#pragma unroll
      for (int e = 0; e < 8; ++e) BTi[(cch * 8 + e) * 128 + l] = (bf16_t)(pk[e >> 1] >> (16 * (e & 1)));
      { const int lc = q >> 4, cc8 = q & 15;
#pragma unroll
        for (int kk = 0; kk < 4; ++kk) raw[j][kk] = *(const u32x4*)(P + (t0 + lc - ((tin0 + lc - 3 + kk >= 0) ? (3 - kk) : 0)) * 5120 + 2048 + 2560 + g * 128 + cc8 * 8); }
    }
#pragma unroll
    for (int j = 0; j < 4; ++j) {
      const int q = tid + 512 * j, l = q >> 4, cch = q & 15;
      float v[8];
      { const f32x4 b0 = *(const f32x4*)(sW + 640 + 512 + cch * 8), b1 = *(const f32x4*)(sW + 640 + 512 + cch * 8 + 4);
        v[0] = b0[0]; v[1] = b0[1]; v[2] = b0[2]; v[3] = b0[3]; v[4] = b1[0]; v[5] = b1[1]; v[6] = b1[2]; v[7] = b1[3]; }
#pragma unroll
      for (int kk = 0; kk < 4; ++kk) {
        float f[8]; unpack8(raw[j][kk], f);
        const float ok = (tin0 + l - 3 + kk >= 0) ? 1.f : 0.f;
        const f32x4 w0 = *(const f32x4*)(sW + 640 + kk * 128 + cch * 8) * ok, w1 = *(const f32x4*)(sW + 640 + kk * 128 + cch * 8 + 4) * ok;
        v[0] += w0[0] * f[0]; v[1] += w0[1] * f[1]; v[2] += w0[2] * f[2]; v[3] += w0[3] * f[3];
        v[4] += w1[0] * f[4]; v[5] += w1[1] * f[5]; v[6] += w1[2] * f[6]; v[7] += w1[3] * f[7];
      }
#pragma unroll
      for (int e = 0; e < 8; ++e) v[e] = silu(v[e]);
      const u32x4 pk = pack8(v);
      *(u32x4*)(sC + swz128(l, cch)) = pk;
      *(u32x4*)(Cci + l * 128 + cch * 8) = pk;
    }
    {
      const int hh = 8 * g + wave;
      const float Ah = -__expf(A_log[hh]);
      const int l0 = 2 * lane;
      const float d0 = dt[(t0 + l0) * 32 + hh] * Ah, d1 = dt[(t0 + l0 + 1) * 32 + hh] * Ah;
      float sc = d0 + d1;
#pragma unroll
      for (int o = 1; o < 64; o <<= 1) { const float v = __shfl_up(sc, o); if (lane >= o) sc += v; }
      acs[(t0 + l0) * 32 + hh] = sc - d1;
      acs[(t0 + l0 + 1) * 32 + hh] = sc;
    }
    LDS_BARRIER();
    const int lt = wave & 3, st0 = (wave >> 2) * 2;
    f32x16 acc[2];
#pragma unroll
    for (int e = 0; e < 2; ++e)
#pragma unroll
      for (int i = 0; i < 16; ++i) acc[e][i] = 0.f;
#pragma unroll
    for (int kk = 0; kk < 8; ++kk) {
      const bf16x8 yf = *(const bf16x8*)(sC + swz128(32 * lt + l31, 2 * kk + h));
#pragma unroll
      for (int e = 0; e < 2; ++e) {
        const bf16x8 xf = *(const bf16x8*)(sB + swz128(32 * (st0 + e) + l31, 2 * kk + h));
        acc[e] = MFMA(xf, yf, acc[e]);
      }
    }
    const int l = 32 * lt + l31;
#pragma unroll
    for (int e = 0; e < 2; ++e)
#pragma unroll
      for (int gi = 0; gi < 4; ++gi) {
        const int s = 32 * (st0 + e) + 8 * gi + 4 * h;
        u32x2 ov; ov[0] = pk2(acc[e][4 * gi], acc[e][4 * gi + 1]); ov[1] = pk2(acc[e][4 * gi + 2], acc[e][4 * gi + 3]);
        *(u32x2*)(CBi + l * 128 + s) = ov;
      }
    LDS_BARRIER();
  }
}

DI void ssd_scan_phase(bf16_t* P, const bf16_t* BT, const bf16_t* Cc, const bf16_t* CB, const float* dt, const float* acs,
                       const float* cw, const float* cb, const float* Dp, char* lds, bool dry, int mode, float* Sbuf) {
  char* sCBL = lds; char* sC = lds + 32768; char* sBT = lds + 65536; char* sXdt = lds + 98304; char* sXds = lds + 106496;
  char* sSt = lds + 114688;
  char* sXs = lds + 131072;
  float* sAcs = (float*)(lds + 141312);
  float* sDt = (float*)(lds + 142336);
  float* sCw = (float*)(lds + 143360);
  const int tid = otid(), lane = tid & 63, wave = tid >> 6, h = lane >> 5, l31 = lane & 31;
  const int r0_ = tid >> 4, cch_ = tid & 15, r0 = r0_, cch = cch_;
  const int xl_ = 2 * ((tid - 256) & 63), xc_ = (tid - 256) >> 6, xl = xl_, xc = xc_;
  for (int item0 = blockIdx.x; item0 < 256; item0 += gridDim.x) {
    const int item = item0 & 127, seg = item0 >> 7, c0 = mode ? seg * 16 : seg * 32, c1 = c0 + (mode ? 16 : 32);
    const bool zero_init = (mode == 1) || (seg == 0);
    const int grp = item & 7, mem = (item >> 3) & 15, b = grp >> 2, g = grp & 3, hh = 8 * g + (mem >> 1), ph = mem & 1;
    const int pcol = hh * 64 + ph * 32;
    const float Dh = Dp[hh];
    f32x16 st;
#pragma unroll
    for (int i = 0; i < 16; ++i) st[i] = 0.f;
    if (zero_init) { for (int q = tid; q < 2048; q += 512) ((unsigned*)sSt)[q] = 0u; }
    else if (wave >= 4) {
      float dsum = 0.f;
      for (int cc = 16; cc < 32; ++cc) dsum += acs[((size_t)b * SEQ + cc * 128 + 127) * 32 + hh];
      const float Db = __expf(dsum);
      const float* spa = Sbuf + ((size_t)item * 4 + (wave - 4)) * 1024 + lane * 16;
      const float* spb = spa + (size_t)128 * 4 * 1024;
#pragma unroll
      for (int gi = 0; gi < 4; ++gi) { const f32x4 va = *(const f32x4*)(spa + 4 * gi), vb = *(const f32x4*)(spb + 4 * gi); const f32x4 v = va * Db + vb;
        st[4 * gi] = v[0]; st[4 * gi + 1] = v[1]; st[4 * gi + 2] = v[2]; st[4 * gi + 3] = v[3];
        u32x2 ov; ov[0] = pk2(v[0], v[1]); ov[1] = pk2(v[2], v[3]);
        *(u32x2*)(sSt + l31 * 256 + (((4 * (wave - 4) + gi) ^ (l31 & 15)) << 4) + 8 * h) = ov; }
    }
    if (tid < 160) sCw[tid] = (tid < 128) ? cw[(tid >> 5) * 3072 + pcol + (tid & 31)] : cb[pcol + tid - 128];
    const size_t tb = (size_t)b * SEQ, tbs = tb + (size_t)c0 * 128;
    const size_t cbi0 = ((size_t)(b * 64) * 4 + g) * 16384;
    const unsigned toff = r0 * 128 + cch * 8;
    const unsigned xoff = xl * 5120 + xc * 8;
    const unsigned zoff = (32 * (wave & 3) + l31) * 5120 + 4 * h;
    u32x4 rC[4], rB[4], rCB[4], rX[5];
    u32x2 cz[4];
    float racs = 0.f, rdt = 0.f;
    unsigned tchA = 0u, tchB = 0u, tsum = 0u;
    {
      const size_t cbis = cbi0 + (size_t)c0 * 65536;
      const bf16_t* Cq = Cc + cbis; const bf16_t* Bq = BT + cbis; const bf16_t* CBq = CB + cbis;
#pragma unroll
      for (int j = 0; j < 4; ++j) { rB[j] = *(const u32x4*)(Bq + toff + j * 4096); rC[j] = (u32x4){0u, 0u, 0u, 0u}; rCB[j] = (u32x4){0u, 0u, 0u, 0u};
        if (mode == 0) { rC[j] = *(const u32x4*)(Cq + toff + j * 4096); rCB[j] = *(const u32x4*)(CBq + toff + j * 4096); } }
      const bf16_t* Xq = P + tbs * 5120 + 2048 + pcol;
#pragma unroll
      for (int kk = 0; kk < 5; ++kk) {
        rX[kk] = (u32x4){0u, 0u, 0u, 0u};
        if (wave >= 4 && (c0 > 0 || xl - 3 + kk >= 0)) rX[kk] = *(const u32x4*)(Xq + (xl - 3 + kk) * 5120 + xc * 8);
      }
      const bf16_t* Zq = P + tbs * 5120 + pcol;
#pragma unroll
      for (int gi = 0; gi < 4; ++gi) cz[gi] = (u32x2){0u, 0u};
      if (wave < 4 && mode == 0) {
#pragma unroll
        for (int gi = 0; gi < 4; ++gi) cz[gi] = *(const u32x2*)(Zq + zoff + 8 * gi);
      }
      const float* aq = acs + tbs * 32 + hh; const float* dq = dt + tbs * 32 + hh;
      if (tid < 128) { sAcs[tid] = aq[tid * 32]; sDt[tid] = dq[tid * 32]; racs = aq[4096 + tid * 32]; rdt = dq[4096 + tid * 32]; }
    }
    __syncthreads();
#pragma unroll 1
    for (int c = c0; c < c1; ++c) {
      const size_t t0 = tb + c * 128;
      const float* cAcs = sAcs + (c & 1) * 128; const float* cDt = sDt + (c & 1) * 128;
      {
        int xl = xl_, xc = xc_, r0 = r0_, cch = cch_;
        asm volatile("" : "+v"(xl), "+v"(xc), "+v"(r0), "+v"(cch));
        const f32x4 a0 = *(const f32x4*)(cAcs + cch * 8), a1 = *(const f32x4*)(cAcs + cch * 8 + 4);
        const float L2E = 1.44269504f;
        const float as[8] = {a0[0] * L2E, a0[1] * L2E, a0[2] * L2E, a0[3] * L2E, a1[0] * L2E, a1[1] * L2E, a1[2] * L2E, a1[3] * L2E};
#pragma unroll
        for (int j = 0; j < 4; ++j) {
          const int r = r0 + 32 * j;
          *(u32x4*)(sBT + swz128(r, cch)) = rB[j];
          if (mode == 0) {
            *(u32x4*)(sC + swz128(r, cch)) = rC[j];
            float f[8]; unpack8(rCB[j], f);
            const float el = cAcs[r] * L2E;
            const int lim = r - cch * 8;
#pragma unroll
            for (int e = 0; e < 8; ++e) f[e] = (e <= lim) ? f[e] * __builtin_amdgcn_exp2f(el - as[e]) : 0.f;
            *(u32x4*)(sCBL + swz128(r, cch)) = pack8(f);
          }
        }
        if (wave >= 4) {
          float a[8], bq[8];
          { const f32x4 b0 = *(const f32x4*)(sCw + 128 + xc * 8), b1 = *(const f32x4*)(sCw + 128 + xc * 8 + 4);
            a[0] = b0[0]; a[1] = b0[1]; a[2] = b0[2]; a[3] = b0[3]; a[4] = b1[0]; a[5] = b1[1]; a[6] = b1[2]; a[7] = b1[3]; }
#pragma unroll
          for (int e = 0; e < 8; ++e) bq[e] = a[e];
#pragma unroll
          for (int kk = 0; kk < 4; ++kk) {
            float f[8], f2[8]; unpack8(rX[kk], f); unpack8(rX[kk + 1], f2);
            const f32x4 w0 = *(const f32x4*)(sCw + kk * 32 + xc * 8), w1 = *(const f32x4*)(sCw + kk * 32 + xc * 8 + 4);
            a[0] += w0[0] * f[0]; a[1] += w0[1] * f[1]; a[2] += w0[2] * f[2]; a[3] += w0[3] * f[3];
            a[4] += w1[0] * f[4]; a[5] += w1[1] * f[5]; a[6] += w1[2] * f[6]; a[7] += w1[3] * f[7];
            bq[0] += w0[0] * f2[0]; bq[1] += w0[1] * f2[1]; bq[2] += w0[2] * f2[2]; bq[3] += w0[3] * f2[3];
            bq[4] += w1[0] * f2[4]; bq[5] += w1[1] * f2[5]; bq[6] += w1[2] * f2[6]; bq[7] += w1[3] * f2[7];
          }
#pragma unroll
          for (int e = 0; e < 8; ++e) { a[e] = silu(a[e]); bq[e] = silu(bq[e]); }
          if (mode == 0) { *(u32x4*)(sXs + xl * 80 + xc * 16) = pack8(a); *(u32x4*)(sXs + (xl + 1) * 80 + xc * 16) = pack8(bq); }
          const float e127 = cAcs[127];
          const float dlA = cDt[xl], dlB = cDt[xl + 1];
          const float dsA = dlA * __expf(e127 - cAcs[xl]), dsB = dlB * __expf(e127 - cAcs[xl + 1]);
#pragma unroll
          for (int e = 0; e < 8; ++e) {
            const int pr = xc * 8 + e;
            const int off = pr * 256 + (((xl >> 3) ^ (pr & 15)) << 4) + (xl & 7) * 2;
            if (mode == 0) *(unsigned*)(sXdt + off) = pk2(a[e] * dlA, bq[e] * dlB);
            *(unsigned*)(sXds + off) = pk2(a[e] * dsA, bq[e] * dsB);
          }
        }
      }
      float nacs = 0.f, ndt = 0.f;
      tsum += tchA + tchB;
      if (c + 2 < c1) {
        const size_t cb2 = cbi0 + (size_t)(c + 2) * 65536;
        const int tl = tid & 255;
        tchA = *(const unsigned*)((tid < 256 ? Cc : BT) + cb2 + tl * 64);
        const bf16_t* rowp = P + (t0 + 256 + (tid & 127)) * 5120 + pcol + ((tid < 384) ? 2048 : 0);
        tchB = *(const unsigned*)((tid < 256) ? (CB + cb2 + tl * 64) : rowp);
      }
      if (c + 1 < c1) {
        if (c + 2 < c1 && tid < 128) { nacs = (acs + (t0 + 256) * 32 + hh)[tid * 32]; ndt = (dt + (t0 + 256) * 32 + hh)[tid * 32]; }
        const size_t cbi = cbi0 + (size_t)(c + 1) * 65536;
        const bf16_t* Cq = Cc + cbi; const bf16_t* Bq = BT + cbi; const bf16_t* CBq = CB + cbi;
#pragma unroll
        for (int j = 0; j < 4; ++j) { rB[j] = *(const u32x4*)(Bq + toff + j * 4096); if (mode == 0) { rC[j] = *(const u32x4*)(Cq + toff + j * 4096); rCB[j] = *(const u32x4*)(CBq + toff + j * 4096); } }
        const bf16_t* Xq = P + (t0 + 125) * 5120 + 2048 + pcol;
#pragma unroll
        for (int kk = 0; kk < 5; ++kk) { if (wave >= 4) rX[kk] = *(const u32x4*)(Xq + xoff + kk * 5120); }
      }
      __builtin_amdgcn_sched_barrier(0);
      LDS_BARRIER();
      int lq = l31, hq = h;
      asm volatile("" : "+v"(lq), "+v"(hq));
      if (wave < 4) {
       if (mode == 0) {
        const int lt = wave;
        f32x16 ad, ao;
#pragma unroll
        for (int i = 0; i < 16; ++i) { ad[i] = 0.f; ao[i] = 0.f; }
        const char* stb = sSt + (c & 1) * 8192;
#pragma unroll
        for (int kk = 0; kk < 8; ++kk) {
          const bf16x8 yf = *(const bf16x8*)(sCBL + swz128(32 * lt + lq, 2 * kk + hq));
          const bf16x8 xf = *(const bf16x8*)(sXdt + swz128(lq, 2 * kk + hq));
          ad = MFMA(xf, yf, ad);
          const bf16x8 yf2 = *(const bf16x8*)(sC + swz128(32 * lt + lq, 2 * kk + hq));
          const bf16x8 xf2 = *(const bf16x8*)(stb + swz128(lq, 2 * kk + hq));
          ao = MFMA(xf2, yf2, ao);
        }
        const int l = 32 * lt + l31;
        const float eo = __expf(cAcs[l]);
        bf16_t* Zq = P + t0 * 5120 + pcol;
#pragma unroll
        for (int gi = 0; gi < 4; ++gi) {
          const int p0 = 8 * gi + 4 * h;
          const u32x2 xsv = *(const u32x2*)(sXs + l * 80 + p0 * 2);
          const u32x2 zv = cz[gi];
          const float xs0 = bflo(xsv[0]), xs1 = bfhi(xsv[0]), xs2 = bflo(xsv[1]), xs3 = bfhi(xsv[1]);
          const float z0 = bflo(zv[0]), z1 = bfhi(zv[0]), z2 = bflo(zv[1]), z3 = bfhi(zv[1]);
          const float y0 = (ad[4 * gi] + eo * ao[4 * gi] + Dh * xs0) * silu(z0);
          const float y1 = (ad[4 * gi + 1] + eo * ao[4 * gi + 1] + Dh * xs1) * silu(z1);
          const float y2 = (ad[4 * gi + 2] + eo * ao[4 * gi + 2] + Dh * xs2) * silu(z2);
          const float y3 = (ad[4 * gi + 3] + eo * ao[4 * gi + 3] + Dh * xs3) * silu(z3);
          u32x2 ov; ov[0] = pk2(y0, y1); ov[1] = pk2(y2, y3);
          if (!dry) *(u32x2*)(Zq + zoff + 8 * gi) = ov;
        }
        if (c + 1 < c1) {
#pragma unroll
          for (int gi = 0; gi < 4; ++gi) cz[gi] = *(const u32x2*)(Zq + 128 * 5120 + zoff + 8 * gi);
        }
       }
      } else {
        const int nt = wave - 4;
        const float dec = __expf(cAcs[127]);
#pragma unroll
        for (int i = 0; i < 16; ++i) st[i] *= dec;
#pragma unroll
        for (int kk = 0; kk < 8; ++kk) {
          const bf16x8 xf = *(const bf16x8*)(sBT + swz128(32 * nt + lq, 2 * kk + hq));
          const bf16x8 yf = *(const bf16x8*)(sXds + swz128(lq, 2 * kk + hq));
          st = MFMA(xf, yf, st);
        }
        char* stn = sSt + ((c + 1) & 1) * 8192;
#pragma unroll
        for (int gi = 0; gi < 4; ++gi) {
          u32x2 ov; ov[0] = pk2(st[4 * gi], st[4 * gi + 1]); ov[1] = pk2(st[4 * gi + 2], st[4 * gi + 3]);
          *(u32x2*)(stn + l31 * 256 + (((4 * nt + gi) ^ (l31 & 15)) << 4) + 8 * h) = ov;
        }
      }
      if (tid < 128) { sAcs[((c + 1) & 1) * 128 + tid] = racs; sDt[((c + 1) & 1) * 128 + tid] = rdt; }
      racs = nacs; rdt = ndt;
      LDS_BARRIER();
    }
    if (mode == 1 && wave >= 4) {
      float* sp = Sbuf + ((size_t)(seg * 128 + item) * 4 + (wave - 4)) * 1024 + lane * 16;
#pragma unroll
      for (int gi = 0; gi < 4; ++gi) { f32x4 v; v[0] = st[4 * gi]; v[1] = st[4 * gi + 1]; v[2] = st[4 * gi + 2]; v[3] = st[4 * gi + 3]; *(f32x4*)(sp + 4 * gi) = v; }
    }
    __syncthreads();
    if (tsum == 0x9e3779b9u && dry) sDt[0] = 1.f;
  }
}

DI void gnorm_phase(bf16_t* P, const float* nw, bool dry) {
  const int tid = otid(), lane = tid & 63, wave = tid >> 6;
  const int stride = gridDim.x * 8;
  for (int rg0 = blockIdx.x * 8 + wave; rg0 < T * 4; rg0 += stride * 4) {
    u32x4 r[4];
#pragma unroll
    for (int k = 0; k < 4; ++k) { const int rg = rg0 + k * stride; const int rgc = (rg < T * 4) ? rg : rg0; r[k] = *(const u32x4*)(P + (size_t)(rgc >> 2) * 5120 + (rgc & 3) * 512 + lane * 8); }
#pragma unroll
    for (int k = 0; k < 4; ++k) {
      const int rg = rg0 + k * stride;
      if (rg < T * 4) {
        const int t = rg >> 2, g = rg & 3;
        float f[8]; unpack8(r[k], f);
        float ss = 0.f;
#pragma unroll
        for (int e = 0; e < 8; ++e) ss += f[e] * f[e];
        ss = wave_sum(ss);
        const float rstd = rsqrtf(ss * (1.f / 512.f) + 1e-5f);
        const f32x4 w0 = *(const f32x4*)(nw + g * 512 + lane * 8), w1 = *(const f32x4*)(nw + g * 512 + lane * 8 + 4);
        f[0] *= rstd * w0[0]; f[1] *= rstd * w0[1]; f[2] *= rstd * w0[2]; f[3] *= rstd * w0[3];
        f[4] *= rstd * w1[0]; f[5] *= rstd * w1[1]; f[6] *= rstd * w1[2]; f[7] *= rstd * w1[3];
        if (!dry) *(u32x4*)(P + (size_t)t * 5120 + g * 512 + lane * 8) = pack8(f);
      }
    }
  }
}


#define XB_TMO      128
#define XB_XCNT(j)  (256  + 64 * (j))
#define XB_XSUB(j)  (1280 + 64 * (j))
#define XB_XGEN(j)  (2304 + 64 * (j))
#define XB_TOP      3328
#define XB_TOPGEN   3392
#define XCD_BAR_WORDS 3456
#define XB_SPIN_CAP (1u << 20)
#define LAS3 __attribute__((address_space(3)))
DI unsigned xb_ld(unsigned* p)              { return __hip_atomic_load(p, __ATOMIC_RELAXED, __HIP_MEMORY_SCOPE_AGENT); }
DI unsigned xb_add(unsigned* p, unsigned v) { return __hip_atomic_fetch_add(p, v, __ATOMIC_RELAXED, __HIP_MEMORY_SCOPE_AGENT); }
DI unsigned xb_xcc_id() { return (unsigned)__builtin_amdgcn_s_getreg((3 << 11) | 20) & 0xFu; }
#define XB_SPIN(cond, bar) do { unsigned _sp = 0; while (cond) { __builtin_amdgcn_s_sleep(1); \
    if ((++_sp & 255u) == 0u) { if (xb_ld(&(bar)[XB_TMO])) break; if (_sp > XB_SPIN_CAP) { atomicAdd(&(bar)[XB_TMO], 1u); break; } } } } while (0)
struct XcdBarrier { unsigned* bar; unsigned x; volatile LAS3 unsigned* st; };
DI XcdBarrier xcd_barrier_post(unsigned* bar, volatile LAS3 unsigned* st) {
  XcdBarrier b; b.bar = bar; b.x = xb_xcc_id(); b.st = st;
  if (threadIdx.x == 0) (void)xb_add(&bar[XB_XCNT(b.x)], 1u);
  return b;
}
DI void xcd_barrier_complete(unsigned* bar, unsigned x, unsigned& nloc, unsigned& nx) {
  const unsigned G = gridDim.x * gridDim.y * gridDim.z;
  unsigned sum, cnt, mine, sp = 0u;
  for (;;) {
    sum = 0u; cnt = 0u; mine = 0u;
#pragma unroll
    for (unsigned j = 0; j < 16; ++j) { const unsigned c = xb_ld(&bar[XB_XCNT(j)]); sum += c; cnt += (c > 0u) ? 1u : 0u; mine = (j == x) ? c : mine; }
    if (sum == G) break;
    __builtin_amdgcn_s_sleep(1);
    if ((++sp & 255u) == 0u) { if (xb_ld(&bar[XB_TMO])) break; if (sp > XB_SPIN_CAP) { atomicAdd(&bar[XB_TMO], 1u); break; } }
  }
  nloc = mine > 0u ? mine : 1u; nx = cnt > 0u ? cnt : 1u;
}
DI void xcd_barrier(const XcdBarrier& b) {
  asm volatile("s_waitcnt vmcnt(0)" ::: "memory");
  __syncthreads();
  if (threadIdx.x == 0) {
    unsigned* bar = b.bar;
    __builtin_amdgcn_s_waitcnt(0);
    unsigned nloc = b.st[0], nx = b.st[1];
    if (nloc == 0u) { xcd_barrier_complete(bar, b.x, nloc, nx); b.st[0] = nloc; b.st[1] = nx; }
    const unsigned old = xb_add(&bar[XB_XSUB(b.x)], 1u);
    const unsigned gen = old / nloc;
    if (old + 1u == (gen + 1u) * nloc) {
      __builtin_amdgcn_fence(__ATOMIC_RELEASE, "agent");
      asm volatile("s_waitcnt vmcnt(0)" ::: "memory");
      const unsigned og = xb_add(&bar[XB_TOP], 1u);
      const unsigned tg = og / nx;
      if (og + 1u == (tg + 1u) * nx) xb_add(&bar[XB_TOPGEN], 1u);
      else XB_SPIN(xb_ld(&bar[XB_TOPGEN]) == tg, bar);
      __builtin_amdgcn_fence(__ATOMIC_ACQUIRE, "agent");
      xb_add(&bar[XB_XGEN(b.x)], 1u);
      asm volatile("s_waitcnt vmcnt(0)" ::: "memory");
    } else {
      XB_SPIN(xb_ld(&bar[XB_XGEN(b.x)]) == gen, bar);
      __builtin_amdgcn_fence(__ATOMIC_ACQUIRE, "agent");
      asm volatile("s_waitcnt vmcnt(0)" ::: "memory");
    }
  }
  __syncthreads();
}

DI int phase_kind(int ph, int& L) {
  if (ph == NPH - 1) { L = 0; return 9; }
  if (ph == 0) { L = 0; return 0; }
  int sub;
  if (ph < 6) { L = 0; sub = ph; } else if (ph < 14) { L = 1; sub = ph - 5; } else if (ph < 19) { L = 2; sub = ph - 13; } else { L = 3; sub = ph - 18; }
  if (L & 1) { return (sub < 3) ? sub : (sub == 3) ? 10 : (sub < 7) ? sub - 1 : sub; }
  return (sub < 3) ? sub : ((sub == 3) ? 5 : sub + 3);
}
DI void run_phase(const Params& p, int ph, char* lds, bool dry) {
  int L;
  const int kind = phase_kind(ph, L);
  if (kind == 9) { final_norm_phase(p.S, p.final_norm_w, p.X); return; }
  const int i = L >> 1;
  const bool odd = L & 1;
  bf16_t* Wb = p.Wb;
  switch (kind) {
#if !defined(ONLY) || ((ONLY >> 0) & 1)
    case 0: {
      convert_mixer(p, 0, lds, 0);
      init_stream_phase(p.x, p.S, p.ssq);
    } break;
#endif
#if !defined(ONLY) || ((ONLY >> 1) & 1)
    case 1: {
      if (!odd) { pg8::EpiBf16 e{p.P, 1280, nullptr, nullptr, p.ssq}; gemm_run(p.S, 1024, Wb + W_IN, 1024, 1280, lds, e); }
      else { pg8::EpiBf16 e{p.P, 5120, p.dt, p.ssd_dt_bias + i * 32, p.ssq}; gemm_run(p.S, 1024, Wb + W_IN, 1024, 5376, lds, e); }
      convert_ffn(p, L, lds, idle_from(odd ? 64 * 21 : 64 * 5));
    } break;
#endif
#if !defined(ONLY) || ((ONLY >> 2) & 1)
    case 2: {
      if (!odd) {
        bf16_t* cat = p.P + (size_t)T * 1280;
        attn_phase(p.P, cat, p.ap_sinks + i * 8, lds);
        pool_phase(p.P, cat, Wb + W_POOL, p.pool_scale + i * 512, lds);
      } else {
        ssd_cb_phase(p.P, p.H, p.H + (size_t)512 * 16384, p.CB, p.dt, p.acs, p.ssd_conv_w + (size_t)i * 4 * 3072, p.ssd_conv_b + i * 3072, p.ssd_A_log + i * 32, lds);
      }
    } break;
#endif
#if !defined(ONLY) || ((ONLY >> 3) & 1)
    case 3: case 10: ssd_scan_phase(p.P, p.H, p.H + (size_t)512 * 16384, p.CB, p.dt, p.acs, p.ssd_conv_w + (size_t)i * 4 * 3072, p.ssd_conv_b + i * 3072, p.ssd_D + i * 32, lds, dry, kind == 10 ? 1 : 0, (float*)(p.bar + XCD_BAR_WORDS)); break;
#endif
#if !defined(ONLY) || ((ONLY >> 4) & 1)
    case 4: gnorm_phase(p.P, p.ssd_norm_w + i * 2048, dry); break;
#endif
#if !defined(ONLY) || ((ONLY >> 5) & 1)
    case 5: case 8: {
      pg8::EpiResid e{(kind == 5 && L == 0) ? p.x : nullptr, p.S, p.ssq, dry};
      const bf16_t* A; int lda, K; const bf16_t* Bt;
      if (kind == 8) { A = p.P; lda = 2816; K = 2816; Bt = Wb + W_DN; }
      else if (!odd) { A = p.P + (size_t)T * 1280; lda = 1024; K = 1024; Bt = Wb + W_OUT; }
      else { A = p.P; lda = 5120; K = 2048; Bt = Wb + W_OUT; }
      gemm_run(A, lda, Bt, K, 1024, lds, e);
    } break;
#endif
#if !defined(ONLY) || ((ONLY >> 7) & 1)
    case 7: { pg8::EpiSwiglu e{p.P, p.ssq}; gemm_run(p.S, 1024, Wb + W_GU, 1024, 5632, lds, e); if (L < 3) convert_mixer(p, L + 1, lds, idle_from(64 * 22)); } break;
#endif
    default: break;
  }
}

__global__ void __launch_bounds__(512) mega(Params p, int ph_lo, int ph_hi) {
  extern __shared__ __attribute__((aligned(16))) char lds[];
  volatile LAS3 unsigned* st = (volatile LAS3 unsigned*)(LAS3 char*)(lds + 144000);
  if (threadIdx.x < 4) st[threadIdx.x] = 0u;
  __syncthreads();
  XcdBarrier xb = xcd_barrier_post(p.bar, st);
  for (int ph = ph_lo; ph < ph_hi; ++ph) {
#ifdef DUPMASK
    { int L2; const int kind2 = phase_kind(ph, L2);
      if ((DUPMASK >> kind2) & 1) { run_phase(p, ph, lds, ph_lo == 0); xcd_barrier(xb); } }
#endif
    run_phase(p, ph, lds, false);
    if (ph + 1 < ph_hi) {
      if (ph_hi > 1000) cg::this_grid().sync();
      xcd_barrier(xb);
    }
  }
}

extern "C" void kernel_launch(void* const* d_in, const int* in_sizes, int n_in, void* d_out, int out_size, void* d_ws, size_t ws_size, hipStream_t stream) {
  Params p{};
  const float** f = (const float**)&p;
  for (int i = 0; i < 20; ++i) f[i] = (const float*)d_in[i];
  p.X = (float*)d_out;
  char* ws = (char*)d_ws;
  size_t off = 0;
  p.Wb = (bf16_t*)(ws + off); off += W_TOTAL * 2;
  p.H = (bf16_t*)(ws + off); off += (size_t)T * 1024 * 2;
  p.P = (bf16_t*)(ws + off); off += (size_t)T * 5120 * 2;
  p.S = (bf16_t*)(ws + off); off += (size_t)T * 1024 * 2;
  p.bar = (unsigned*)(ws + off); off += (size_t)XCD_BAR_WORDS * 4;
  off += (size_t)2 * 128 * 4 * 1024 * 4;
  { char* os = (char*)d_out; size_t oo = 0;
    p.CB = (bf16_t*)(os + oo); oo += (size_t)512 * 16384 * 2;
    p.dt = (float*)(os + oo); oo += (size_t)T * 32 * 4;
    p.acs = (float*)(os + oo); oo += (size_t)T * 32 * 4;
    p.ssq = (float*)(os + oo); oo += (size_t)T * 16 * 4; }
  static int grid = 0;
  if (!grid) {
    (void)hipFuncSetAttribute((const void*)mega, hipFuncAttributeMaxDynamicSharedMemorySize, (int)LDS_BYTES);
    int dev = 0, cus = 0, per_cu = 0;
    (void)hipGetDevice(&dev);
    (void)hipDeviceGetAttribute(&cus, hipDeviceAttributeMultiprocessorCount, dev);
    (void)hipOccupancyMaxActiveBlocksPerMultiprocessor(&per_cu, mega, 512, LDS_BYTES);
    if (per_cu < 1) per_cu = 1;
    grid = cus * per_cu;
    if (off > ws_size) fprintf(stderr, "workspace too small: need %zu have %zu\n", off, ws_size);
  }
  (void)hipMemsetAsync(p.bar, 0, (size_t)XCD_BAR_WORDS * 4, stream);
#if COOP
  int lo = 0, hi = NPH;
  void* args[] = {&p, &lo, &hi};
  hipError_t e = hipLaunchCooperativeKernel((void*)mega, dim3(grid), dim3(512), args, LDS_BYTES, stream);
  if (e != hipSuccess) fprintf(stderr, "cooperative launch failed: %s (grid %d)\n", hipGetErrorString(e), grid);
#else
  for (int ph = 0; ph < NPH; ++ph) hipLaunchKernelGGL(mega, dim3(grid), dim3(512), LDS_BYTES, stream, p, ph, ph + 1);
#endif
}
```

```cpp
#include <hip/hip_runtime.h>
#include <hip/hip_cooperative_groups.h>
#include <cstdio>
namespace cg = cooperative_groups;

#ifndef COOP
#define COOP 1
#endif

typedef unsigned short bf16_t;
typedef short bf16x8 __attribute__((ext_vector_type(8)));
typedef short s16x4 __attribute__((ext_vector_type(4)));
typedef float f32x4 __attribute__((ext_vector_type(4)));
typedef float f32x16 __attribute__((ext_vector_type(16)));
typedef unsigned u32x4 __attribute__((ext_vector_type(4)));
typedef unsigned u32x2 __attribute__((ext_vector_type(2)));
typedef __bf16 bf2_t __attribute__((ext_vector_type(2)));
typedef float f32x2 __attribute__((ext_vector_type(2)));

#define DI __device__ __forceinline__
#define MFMA(a, b, c) __builtin_amdgcn_mfma_f32_32x32x16_bf16((a), (b), (c), 0, 0, 0)

constexpr int T = 16384;
constexpr int SEQ = 8192;
constexpr int NPH = 28;
constexpr size_t LDS_BYTES = 144016;

constexpr size_t W_IN = 0, W_OUT = 5505024, W_GU = 7602176, W_DN = 13369344, W_POOL = 16252928, W_TOTAL = 16318464;

struct Params {
  const float *x, *mix_norm_w, *ap_w_in, *ap_sinks, *pool_w, *pool_scale, *ap_w_out, *ssd_w_in, *ssd_conv_w, *ssd_conv_b,
      *ssd_dt_bias, *ssd_A_log, *ssd_D, *ssd_norm_w, *ssd_w_out, *ffn_norm_w, *w_gate, *w_up, *w_down, *final_norm_w;
  float* X;
  bf16_t *Wb, *H, *P, *CB, *S;
  float *dt, *acs, *ssq;
  unsigned* bar;
};

DI unsigned pk2(float lo, float hi) { f32x2 v = {lo, hi}; bf2_t r = __builtin_convertvector(v, bf2_t); return __builtin_bit_cast(unsigned, r); }
DI float bflo(unsigned u) { return __uint_as_float(u << 16); }
DI float bfhi(unsigned u) { return __uint_as_float(u & 0xffff0000u); }
DI float silu(float x) { return x * __builtin_amdgcn_rcpf(1.f + __expf(-x)); }
DI int crow(int i, int h) { return (i & 3) + 8 * (i >> 2) + 4 * h; }
DI int otid() { int t = threadIdx.x; asm volatile("" : "+v"(t)); return t; }
DI float wave_sum(float v) {
#pragma unroll
  for (int o = 32; o >= 1; o >>= 1) v += __shfl_xor(v, o);
  return v;
}
DI void unpack8(u32x4 r, float (&f)[8]) {
#pragma unroll
  for (int e = 0; e < 4; ++e) { f[2 * e] = bflo(r[e]); f[2 * e + 1] = bfhi(r[e]); }
}
DI u32x4 pack8(const float (&f)[8]) { u32x4 r; r[0] = pk2(f[0], f[1]); r[1] = pk2(f[2], f[3]); r[2] = pk2(f[4], f[5]); r[3] = pk2(f[6], f[7]); return r; }
DI int swz64(int r, int c) { return r * 128 + ((c ^ ((r >> 1) & 7)) << 4); }
DI int swz128(int r, int c) { return r * 256 + ((c ^ (r & 15)) << 4); }

namespace pg8 {
#define PG8_LAS __attribute__((address_space(3)))
constexpr int BM = 256, BK = 64, HALF = 128, HTB = HALF * BK * 2, NXCD = 8, WGM = 8;
DI float row_rstd(const float* ssq, int row) { const f32x4* q = (const f32x4*)(ssq + (size_t)row * 16); const f32x4 a = q[0] + q[1] + q[2] + q[3]; return rsqrtf((a[0] + a[1] + a[2] + a[3]) * (1.f / 1024.f) + 1e-5f); }
DI int lds_byte(int r, int c) { const int st = (r >> 4) * 2 + (c >> 5), rr = r & 15, cc = c & 31, ob = rr * 64 + cc * 2; return st * 1024 + (ob ^ (((ob >> 9) & 1) << 5)); }
DI void stage_rc(int b, int& R, int& C) { const int st = b / 1024, sb = b % 1024, swz = sb ^ (((sb >> 9) & 1) << 5); R = (st >> 1) * 16 + swz / 64; C = (st & 1) * 32 + (swz % 64) / 2; }
DI int perm32(int rho) { const int n = rho >> 4, i = rho & 15; return 8 * (i >> 2) + 4 * n + (i & 3); }
struct Unit { int pm, pn; };
struct Gemm { const bf16_t* A; const bf16_t* Bt; int lda, N, K; };
struct StaticOrder {
  int nM, nN, nwg, G, c;
  DI void init(int M, int N, int G_, int c_) { nM = M / BM; nN = N / BM; nwg = nM * nN; G = G_; c = c_; }
  DI bool next(int i, Unit& u) const {
    const long L = (long)i * G + c; if (L >= nwg) return false;
    int wgid = (int)L; { const int q = nwg / NXCD, r = nwg % NXCD, xcd = wgid % NXCD, off = wgid / NXCD; wgid = (xcd < r ? xcd * (q + 1) : r * (q + 1) + (xcd - r) * q) + off; }
    const int nig = WGM * nN, gid = wgid / nig, fm = gid * WGM, gsz = (nM - fm) < WGM ? (nM - fm) : WGM;
    u.pm = fm + ((wgid % nig) % gsz); u.pn = (wgid % nig) / gsz; return true;
  }
};
struct EpiBf16 {
  static constexpr bool PERM = true, RSTD = true;
  bf16_t* C; int ldc; float* dt; const float* bias; const float* ssq;
  DI void operator()(const f32x4 (&acc)[2][2][4][2], const Unit& u, int wr, int wc, int fr, int fq, const PG8_LAS float* sR) const {
    const int row0 = u.pm * BM + wr * 64 + fr;
    if (dt != nullptr && u.pn == 20) {
      if (wc == 0) {
        const f32x4 b0 = *(const f32x4*)(bias + 8 * fq), b1 = *(const f32x4*)(bias + 8 * fq + 4);
#pragma unroll
        for (int ai = 0; ai < 2; ++ai)
#pragma unroll
          for (int m = 0; m < 4; ++m) {
            f32x4 o0, o1;
            const float rs = sR[ai * 128 + m * 16 + fr];
#pragma unroll
            for (int e = 0; e < 4; ++e) {
              const float v0 = acc[ai][0][m][0][e] * rs + b0[e], v1 = acc[ai][0][m][1][e] * rs + b1[e];
              o0[e] = fmaxf(v0, 0.f) + log1pf(__expf(-fabsf(v0))); o1[e] = fmaxf(v1, 0.f) + log1pf(__expf(-fabsf(v1)));
            }
            float* dp = dt + (size_t)(row0 + ai * HALF + m * 16) * 32 + 8 * fq;
            *(f32x4*)dp = o0; *(f32x4*)(dp + 4) = o1;
          }
      }
      return;
    }
    const int col0 = u.pn * BM + wc * 32 + 8 * fq;
#pragma unroll
    for (int ai = 0; ai < 2; ++ai)
#pragma unroll
      for (int m = 0; m < 4; ++m) {
        bf16_t* rowp = C + (size_t)(row0 + ai * HALF + m * 16) * ldc + col0;
        const float rs = sR[ai * 128 + m * 16 + fr];
#pragma unroll
        for (int bj = 0; bj < 2; ++bj) {
          const f32x4 v0 = acc[ai][bj][m][0] * rs, v1 = acc[ai][bj][m][1] * rs;
          u32x4 w; w[0] = pk2(v0[0], v0[1]); w[1] = pk2(v0[2], v0[3]); w[2] = pk2(v1[0], v1[1]); w[3] = pk2(v1[2], v1[3]);
          *(u32x4*)(rowp + bj * HALF) = w;
        }
      }
  }
};
struct EpiResid {
  static constexpr bool PERM = false, RSTD = false;
  const float* X0; bf16_t* S; float* ssq; bool dry;
  DI void operator()(const f32x4 (&acc)[2][2][4][2], const Unit& u, int wr, int wc, int fr, int fq, const PG8_LAS float* sR) const {
    const int row0 = u.pm * BM + wr * 64 + fr, col0 = u.pn * BM + wc * 32 + 4 * fq;
    u32x2 sv[2][4][2][2];
#pragma unroll
    for (int ai = 0; ai < 2; ++ai)
#pragma unroll
      for (int m = 0; m < 4; ++m)
#pragma unroll
        for (int bj = 0; bj < 2; ++bj)
#pragma unroll
          for (int n = 0; n < 2; ++n) {
            sv[ai][m][bj][n] = (u32x2){0u, 0u};
            if (X0 == nullptr) sv[ai][m][bj][n] = *(const u32x2*)(S + (size_t)(row0 + ai * HALF + m * 16) * 1024 + col0 + bj * HALF + n * 16);
          }
#pragma unroll
    for (int ai = 0; ai < 2; ++ai) {
#pragma unroll
      for (int m = 0; m < 4; ++m) {
        const int row = row0 + ai * HALF + m * 16;
        const size_t ro = (size_t)row * 1024 + col0;
        float ss = 0.f;
#pragma unroll
        for (int bj = 0; bj < 2; ++bj)
#pragma unroll
          for (int n = 0; n < 2; ++n) {
            f32x4 v;
            if (X0 != nullptr) v = *(const f32x4*)(X0 + ro + bj * HALF + n * 16);
            else { const u32x2 q = sv[ai][m][bj][n]; v[0] = bflo(q[0]); v[1] = bfhi(q[0]); v[2] = bflo(q[1]); v[3] = bfhi(q[1]); }
            v += acc[ai][bj][m][n];
            ss += v[0] * v[0] + v[1] * v[1] + v[2] * v[2] + v[3] * v[3];
            if (!dry) { u32x2 q; q[0] = pk2(v[0], v[1]); q[1] = pk2(v[2], v[3]); *(u32x2*)(S + ro + bj * HALF + n * 16) = q; }
          }
        ss += __shfl_xor(ss, 16); ss += __shfl_xor(ss, 32);
        if (!dry && fq == 0) ssq[(size_t)row * 16 + u.pn * 4 + wc] = ss;
      }
    }
  }
};
struct EpiSwiglu {
  static constexpr bool PERM = false, RSTD = true;
  bf16_t* Hd; const float* ssq;
  DI void operator()(const f32x4 (&acc)[2][2][4][2], const Unit& u, int wr, int wc, int fr, int fq, const PG8_LAS float* sR) const {
    const int row0 = u.pm * BM + wr * 64 + fr, j0 = (u.pn * BM + wc * 32) / 2 + 4 * fq;
#pragma unroll
    for (int ai = 0; ai < 2; ++ai)
#pragma unroll
      for (int m = 0; m < 4; ++m) {
        bf16_t* rowp = Hd + (size_t)(row0 + ai * HALF + m * 16) * 2816 + j0;
        const float rs = sR[ai * 128 + m * 16 + fr];
#pragma unroll
        for (int bj = 0; bj < 2; ++bj) {
          const f32x4 g = acc[ai][bj][m][0] * rs, up = acc[ai][bj][m][1] * rs;
          u32x2 o; o[0] = pk2(silu(g[0]) * up[0], silu(g[1]) * up[1]); o[1] = pk2(silu(g[2]) * up[2], silu(g[3]) * up[3]);
          *(u32x2*)(rowp + bj * (HALF / 2)) = o;
        }
      }
  }
};

template <class Epi>
DI void gemm_phase(PG8_LAS unsigned char* lds, const Gemm g, const StaticOrder& S, const Epi& E) {
  const int tid = otid(), wid = __builtin_amdgcn_readfirstlane(tid >> 6), lane = tid & 63, wr = wid >> 2, wc = wid & 3, fr = lane & 15, fq = lane >> 4;
  const int K = g.K, nt = K / BK;
  unsigned voffA[2], voffB[2];
#pragma unroll
  for (int i = 0; i < 2; ++i) { int R, C; stage_rc(tid * 16 + i * 8192, R, C); const int Rb = Epi::PERM ? ((R & ~31) + perm32(R & 31)) : R;
    voffA[i] = (unsigned)(R * g.lda + C) * 2u; voffB[i] = (unsigned)(Rb * K + C) * 2u; }
  const size_t kstep = (size_t)(BK * 2);
  const size_t hstepA = (size_t)HALF * g.lda * 2, hstepB = (size_t)HALF * K * 2;
  const size_t tstepA = 2 * hstepA, tstepB = 2 * hstepB;
  const unsigned ldsw = (unsigned)wid * 1024u;
  const int aoff = lds_byte(wr * 64 + fr, fq * 8), boff = lds_byte(wc * 32 + fr, fq * 8);
#define PG8_SA(b, h) (((b) * 2 + (h)) * HTB)
#define PG8_SB(b, h) ((4 + (b) * 2 + (h)) * HTB)
#define PG8_STAGE(bufoff, gbase, voff) do { _Pragma("unroll") for (int _i = 0; _i < 2; ++_i) \
    __builtin_amdgcn_global_load_lds((const unsigned*)((const char*)(gbase) + (voff)[_i]), (PG8_LAS unsigned*)(lds + (bufoff) + ldsw + _i * 8192), 16, 0, 0); } while (0)
#define PG8_LDA(dst, b, h) do { _Pragma("unroll") for (int m = 0; m < 4; ++m) _Pragma("unroll") for (int k = 0; k < 2; ++k) dst[m][k] = *(const PG8_LAS bf16x8*)(lds + PG8_SA(b, h) + aoff + m * 2048 + k * 1024); } while (0)
#define PG8_LDB(dst, b, h) do { _Pragma("unroll") for (int n = 0; n < 2; ++n) _Pragma("unroll") for (int k = 0; k < 2; ++k) dst[n][k] = *(const PG8_LAS bf16x8*)(lds + PG8_SB(b, h) + boff + n * 2048 + k * 1024); } while (0)
#define PG8_MMA(ai, bj, At, Bt) do { __builtin_amdgcn_s_setprio(1); _Pragma("unroll") for (int m = 0; m < 4; ++m) _Pragma("unroll") for (int n = 0; n < 2; ++n) _Pragma("unroll") for (int k = 0; k < 2; ++k) \
    acc[ai][bj][m][n] = __builtin_amdgcn_mfma_f32_16x16x32_bf16(Bt[n][k], At[m][k], acc[ai][bj][m][n], 0, 0, 0); __builtin_amdgcn_s_setprio(0); } while (0)
#define PG8_WAIT_V(n) asm volatile("s_waitcnt vmcnt(" #n ")" ::: "memory")
#define PG8_WAIT_L(n) asm volatile("s_waitcnt lgkmcnt(" #n ")" ::: "memory")
#define PG8_BAR __builtin_amdgcn_s_barrier()
#define PG8_SCHED __builtin_amdgcn_sched_barrier(0)
  Unit cur, nxt; int ui = 0;
  if (!S.next(0, cur)) return;
  f32x4 acc[2][2][4][2];
#pragma unroll
  for (int a = 0; a < 2; ++a)
#pragma unroll
    for (int b = 0; b < 2; ++b)
#pragma unroll
      for (int m = 0; m < 4; ++m)
#pragma unroll
        for (int n = 0; n < 2; ++n) acc[a][b][m][n] = (f32x4){0.f, 0.f, 0.f, 0.f};
  bf16x8 At[4][2], B0[2][2], B1[2][2];
  const char* cA = (const char*)g.A + (size_t)cur.pm * tstepA; const char* cB = (const char*)g.Bt + (size_t)cur.pn * tstepB;
  PG8_STAGE(PG8_SB(0, 0), cB, voffB); PG8_STAGE(PG8_SA(0, 0), cA, voffA); PG8_STAGE(PG8_SB(0, 1), cB + hstepB, voffB); PG8_STAGE(PG8_SA(0, 1), cA + hstepA, voffA);
  if (wr == 1) PG8_BAR;
  PG8_WAIT_V(4); PG8_BAR;
  PG8_STAGE(PG8_SB(1, 0), cB + kstep, voffB); PG8_STAGE(PG8_SA(1, 0), cA + kstep, voffA); PG8_STAGE(PG8_SB(1, 1), cB + hstepB + kstep, voffB);
  PG8_WAIT_V(6); PG8_BAR;
  for (;;) {
    const bool has_next = S.next(ui + 1, nxt);
    const char* nA = has_next ? (const char*)g.A + (size_t)nxt.pm * tstepA : cA; const char* nB = has_next ? (const char*)g.Bt + (size_t)nxt.pn * tstepB : cB;
    for (int t = 0; t < nt; t += 2) {
      const bool last = (t == nt - 2);
      const char* a1 = cA + (size_t)(t + 1) * kstep;
      const char* a2 = last ? nA : cA + (size_t)(t + 2) * kstep; const char* b2 = last ? nB : cB + (size_t)(t + 2) * kstep;
      const char* a3 = a2 + kstep; const char* b3 = b2 + kstep;
      PG8_LDB(B0, 0, 0); PG8_SCHED; PG8_LDA(At, 0, 0); PG8_STAGE(PG8_SA(1, 1), a1 + hstepA, voffA);
      PG8_WAIT_L(8); PG8_BAR; PG8_WAIT_L(0); PG8_MMA(0, 0, At, B0); PG8_BAR; PG8_SCHED;
      PG8_LDB(B1, 0, 1); PG8_STAGE(PG8_SB(0, 0), b2, voffB);
      PG8_BAR; PG8_WAIT_L(0); PG8_MMA(0, 1, At, B1); PG8_BAR;
      PG8_LDA(At, 0, 1); PG8_STAGE(PG8_SA(0, 0), a2, voffA);
      PG8_BAR; PG8_WAIT_L(0); PG8_MMA(1, 0, At, B0); PG8_BAR; PG8_SCHED;
      PG8_STAGE(PG8_SB(0, 1), b2 + hstepB, voffB);
      PG8_WAIT_V(6); PG8_BAR; PG8_MMA(1, 1, At, B1); PG8_BAR;
      PG8_LDB(B0, 1, 0); PG8_SCHED; PG8_LDA(At, 1, 0); PG8_STAGE(PG8_SA(0, 1), a2 + hstepA, voffA);
      PG8_WAIT_L(8); PG8_BAR; PG8_WAIT_L(0); PG8_MMA(0, 0, At, B0); PG8_BAR; PG8_SCHED;
      PG8_LDB(B1, 1, 1); PG8_STAGE(PG8_SB(1, 0), b3, voffB);
      PG8_BAR; PG8_WAIT_L(0); PG8_MMA(0, 1, At, B1); PG8_BAR;
      PG8_LDA(At, 1, 1); PG8_STAGE(PG8_SA(1, 0), a3, voffA);
      PG8_BAR; PG8_WAIT_L(0); PG8_MMA(1, 0, At, B0); PG8_BAR; PG8_SCHED;
      PG8_STAGE(PG8_SB(1, 1), b3 + hstepB, voffB);
      PG8_WAIT_V(6); PG8_BAR; PG8_MMA(1, 1, At, B1); PG8_BAR;
    }
    const PG8_LAS float* sR = (const PG8_LAS float*)(lds + 131072) + ui * 256 + wr * 64;
    E(acc, cur, wr, wc, fr, fq, sR);
    if (!has_next) break;
#pragma unroll
    for (int a = 0; a < 2; ++a)
#pragma unroll
      for (int b = 0; b < 2; ++b)
#pragma unroll
        for (int m = 0; m < 4; ++m)
#pragma unroll
          for (int n = 0; n < 2; ++n) acc[a][b][m][n] = (f32x4){0.f, 0.f, 0.f, 0.f};
    cur = nxt; cA = nA; cB = nB; ++ui;
  }
  PG8_WAIT_V(0);
  if (wr == 0) PG8_BAR;
  PG8_BAR;
#undef PG8_SA
#undef PG8_SB
#undef PG8_STAGE
#undef PG8_LDA
#undef PG8_LDB
#undef PG8_MMA
#undef PG8_WAIT_V
#undef PG8_WAIT_L
#undef PG8_BAR
#undef PG8_SCHED
}
}

template <class Epi>
DI void gemm_run(const bf16_t* A, int lda, const bf16_t* Bt, int K, int N, char* lds, const Epi& e) {
  pg8::Gemm g{A, Bt, lda, N, K};
  pg8::StaticOrder S; S.init(T, N, (int)gridDim.x, (int)blockIdx.x);
  if constexpr (Epi::RSTD) {
    __attribute__((address_space(3))) float* sRall = (__attribute__((address_space(3))) float*)(lds + 131072);
    pg8::Unit u;
    const int tq = otid();
    for (int i = tq >> 8; S.next(i, u); i += 2) sRall[i * 256 + (tq & 255)] = pg8::row_rstd(e.ssq, u.pm * 256 + (tq & 255));
  }
  __syncthreads();
  pg8::gemm_phase(( __attribute__((address_space(3))) unsigned char*)lds, g, S, e);
  __syncthreads();
}

DI void init_stream_phase(const float* Xin, bf16_t* S, float* ssq) {
  const int tid = otid(), lane = tid & 63, wave = tid >> 6;
  const int stride = gridDim.x * 8;
  for (int row0 = blockIdx.x * 8 + wave; row0 < T; row0 += stride * 2) {
    f32x4 v[2][4];
#pragma unroll
    for (int k = 0; k < 2; ++k) { const int row = (row0 + k * stride < T) ? row0 + k * stride : row0; const f32x4* xr = (const f32x4*)(Xin + (size_t)row * 1024);
#pragma unroll
      for (int j = 0; j < 4; ++j) v[k][j] = xr[lane + 64 * j]; }
#pragma unroll
    for (int k = 0; k < 2; ++k) {
      const int row = row0 + k * stride;
      if (row < T) {
        float ss = 0.f;
#pragma unroll
        for (int j = 0; j < 4; ++j) ss += v[k][j][0] * v[k][j][0] + v[k][j][1] * v[k][j][1] + v[k][j][2] * v[k][j][2] + v[k][j][3] * v[k][j][3];
        ss = wave_sum(ss);
#pragma unroll
        for (int j = 0; j < 4; ++j) { u32x2 q; q[0] = pk2(v[k][j][0], v[k][j][1]); q[1] = pk2(v[k][j][2], v[k][j][3]); *(u32x2*)(S + (size_t)row * 1024 + 4 * (lane + 64 * j)) = q; }
        if (lane < 16) ssq[(size_t)row * 16 + lane] = (lane == 0) ? ss : 0.f;
      }
    }
  }
}
DI void final_norm_phase(const bf16_t* S, const float* w, float* out) {
  const int tid = otid(), lane = tid & 63, wave = tid >> 6;
  const int stride = gridDim.x * 8;
  f32x4 wv[4];
#pragma unroll
  for (int q = 0; q < 4; ++q) wv[q] = *(const f32x4*)(w + (q >> 1) * 512 + lane * 8 + (q & 1) * 4);
  for (int row0 = blockIdx.x * 8 + wave; row0 < T; row0 += stride * 4) {
    u32x4 r[4][2];
#pragma unroll
    for (int k = 0; k < 4; ++k) { const int row = (row0 + k * stride < T) ? row0 + k * stride : row0;
      r[k][0] = *(const u32x4*)(S + (size_t)row * 1024 + lane * 8); r[k][1] = *(const u32x4*)(S + (size_t)row * 1024 + 512 + lane * 8); }
#pragma unroll
    for (int k = 0; k < 4; ++k) {
      const int row = row0 + k * stride;
      if (row < T) {
        float f[16];
        { float a[8], b2[8]; unpack8(r[k][0], a); unpack8(r[k][1], b2);
#pragma unroll
          for (int e = 0; e < 8; ++e) { f[e] = a[e]; f[8 + e] = b2[e]; } }
        float ss = 0.f;
#pragma unroll
        for (int e = 0; e < 16; ++e) ss += f[e] * f[e];
        ss = wave_sum(ss);
        const float rstd = rsqrtf(ss * (1.f / 1024.f) + 1e-5f);
#pragma unroll
        for (int hlf = 0; hlf < 2; ++hlf) {
          const int c0 = hlf * 512 + lane * 8;
          f32x4 o0, o1;
#pragma unroll
          for (int e = 0; e < 4; ++e) { o0[e] = f[hlf * 8 + e] * rstd * wv[2 * hlf][e]; o1[e] = f[hlf * 8 + 4 + e] * rstd * wv[2 * hlf + 1][e]; }
          *(f32x4*)(out + (size_t)row * 1024 + c0) = o0; *(f32x4*)(out + (size_t)row * 1024 + c0 + 4) = o1;
        }
      }
    }
  }
}

#define LDS_BARRIER() do { asm volatile("s_waitcnt lgkmcnt(0)" ::: "memory"); __builtin_amdgcn_s_barrier(); asm volatile("" ::: "memory"); } while (0)
struct CvtJob { const float* src; bf16_t* dst; const float* kscale; int K, N, Npad, mode, ntiles; };
DI CvtJob cvt_job(const float* src, int K, int N, bf16_t* dst, int Npad, int mode, const float* kscale) {
  CvtJob j; j.src = src; j.dst = dst; j.kscale = kscale; j.K = K; j.N = N; j.Npad = Npad; j.mode = mode; j.ntiles = (K >> 6) * ((Npad + 255) >> 8); return j;
}
DI void convert_tile(const CvtJob& jb, int ti, char* lds) {
  float* tile = (float*)lds;
  const int tid = otid();
  const int K = jb.K, N = jb.N;
  const int nkt = K >> 6;
  const int kt = ti % nkt, nt = ti / nkt, k0 = kt * 64, n0 = nt * 256;
  const int nn = tid & 255, kr = tid >> 8;
  const int n = n0 + nn;
  float v[32];
#pragma unroll
  for (int i = 0; i < 32; ++i) v[i] = (n < N) ? jb.src[(size_t)(k0 + kr + 2 * i) * N + n] : 0.f;
#pragma unroll
  for (int i = 0; i < 32; ++i) { const int k = kr + 2 * i; tile[k * 257 + nn] = jb.kscale ? v[i] * jb.kscale[k0 + k] : v[i]; }
  __syncthreads();
#pragma unroll
  for (int j = 0; j < 4; ++j) {
    const int q = tid + 512 * j, nw = q >> 3, kc = q & 7;
    float f[8];
#pragma unroll
    for (int e = 0; e < 8; ++e) f[e] = tile[(kc * 8 + e) * 257 + nw];
    const int nr = n0 + nw;
    if (nr < jb.Npad) {
      const int drow = (jb.mode == 0) ? nr : (32 * (nr >> 4) + (nr & 15) + (jb.mode == 2 ? 16 : 0));
      *(u32x4*)(jb.dst + (size_t)drow * K + k0 + kc * 8) = pack8(f);
    }
  }
  LDS_BARRIER();
}
template <int NJ>
DI void convert_jobs(const CvtJob (&jobs)[NJ], char* lds, int first_blk) {
  if ((int)blockIdx.x < first_blk) return;
  int total = 0;
#pragma unroll
  for (int j = 0; j < NJ; ++j) total += jobs[j].ntiles;
  for (int ti = (int)blockIdx.x - first_blk; ti < total; ti += (int)gridDim.x - first_blk) {
    int rem = ti; bool done = false;
#pragma unroll
    for (int j = 0; j < NJ; ++j) {
      if (!done) { if (rem < jobs[j].ntiles) { convert_tile(jobs[j], rem, lds); done = true; } else rem -= jobs[j].ntiles; }
    }
  }
}
DI void convert_ffn(const Params& p, int L, char* lds, int first_blk) {
  const float* nw2 = p.ffn_norm_w + L * 1024;
  const CvtJob jobs[3] = {
    cvt_job(p.w_gate + (size_t)L * 1024 * 2816, 1024, 2816, p.Wb + W_GU, 2816, 1, nw2), cvt_job(p.w_up + (size_t)L * 1024 * 2816, 1024, 2816, p.Wb + W_GU, 2816, 2, nw2),
    cvt_job(p.w_down + (size_t)L * 2816 * 1024, 2816, 1024, p.Wb + W_DN, 1024, 0, nullptr)};
  convert_jobs(jobs, lds, first_blk);
}
DI void convert_mixer(const Params& p, int L, char* lds, int first_blk) {
  const int i = L >> 1; bf16_t* Wb = p.Wb;
  const float* nw1 = p.mix_norm_w + L * 1024;
  if (!(L & 1)) {
    const CvtJob jobs[6] = {
      cvt_job(p.ap_w_in + (size_t)i * 1024 * 1280, 1024, 1280, Wb + W_IN, 1280, 0, nw1), cvt_job(p.ap_w_out + (size_t)i * 1024 * 1024, 1024, 1024, Wb + W_OUT, 1024, 0, nullptr),
      cvt_job(p.pool_w + (size_t)(i * 4 + 0) * 16384, 128, 128, Wb + W_POOL, 128, 0, nullptr), cvt_job(p.pool_w + (size_t)(i * 4 + 1) * 16384, 128, 128, Wb + W_POOL + 16384, 128, 0, nullptr),
      cvt_job(p.pool_w + (size_t)(i * 4 + 2) * 16384, 128, 128, Wb + W_POOL + 32768, 128, 0, nullptr), cvt_job(p.pool_w + (size_t)(i * 4 + 3) * 16384, 128, 128, Wb + W_POOL + 49152, 128, 0, nullptr)};
    convert_jobs(jobs, lds, first_blk);
  } else {
    const CvtJob jobs[2] = {
      cvt_job(p.ssd_w_in + (size_t)i * 1024 * 5152, 1024, 5152, Wb + W_IN, 5376, 0, nw1), cvt_job(p.ssd_w_out + (size_t)i * 2048 * 1024, 2048, 1024, Wb + W_OUT, 1024, 0, nullptr)};
    convert_jobs(jobs, lds, first_blk);
  }
}
DI int idle_from(int nunits) { const int r = nunits % (int)gridDim.x; return r; }

DI void attn_phase(const bf16_t* proj, bf16_t* cat, const float* sinks, char* lds) {
  char* sK = lds; char* sVt = lds + 32768;
  const int tid = otid(), lane = tid & 63, wave = tid >> 6, h = lane >> 5, l31 = lane & 31;
  const int swz = (lane >> 1) & 7;
  for (int item = blockIdx.x; item < 256; item += gridDim.x) {
    const int kvh = item & 1, nb = (item >> 1) & 63, b = item >> 7;
    const int tok0 = b * SEQ + nb * 128;
    u32x4 kv[8];
#pragma unroll
    for (int j = 0; j < 4; ++j) {
      const int q = tid + 512 * j;
      { const int key = q >> 3, c = q & 7; const bool ok = (nb > 0 || key >= 128);
        kv[j] = *(const u32x4*)(proj + (size_t)(ok ? (tok0 - 128 + key) : tok0) * 1280 + 512 + kvh * 64 + c * 8); }
      { const int key = q & 255, c = q >> 8; const bool ok = (nb > 0 || key >= 128);
        kv[4 + j] = *(const u32x4*)(proj + (size_t)(ok ? (tok0 - 128 + key) : tok0) * 1280 + 640 + kvh * 64 + c * 8); }
    }
#pragma unroll
    for (int j = 0; j < 4; ++j) {
      const int q = tid + 512 * j, key = q >> 3, c = q & 7;
      u32x4 v = kv[j];
      if (!(nb > 0 || key >= 128)) v = (u32x4){0u, 0u, 0u, 0u};
      *(u32x4*)(sK + swz64(key, c)) = v;
    }
#pragma unroll
    for (int j = 0; j < 4; ++j) {
      const int q = tid + 512 * j, key = q & 255, c = q >> 8;
      u32x4 v = kv[4 + j];
      if (!(nb > 0 || key >= 128)) v = (u32x4){0u, 0u, 0u, 0u};
#pragma unroll
      for (int e = 0; e < 8; ++e) *(bf16_t*)(sVt + (c * 8 + e) * 520 + key * 2) = (bf16_t)(v[e >> 1] >> (16 * (e & 1)));
    }
    __syncthreads();
#pragma unroll 1
    for (int task = 0; task < 2; ++task) {
      const int g = wave >> 1, sb = (wave & 1) * 2 + task, head = kvh * 4 + g, q0 = sb * 32;
      const int qi = q0 + l31;
      const size_t qtok = (size_t)tok0 + qi;
      bf16x8 qf[4];
#pragma unroll
      for (int kk = 0; kk < 4; ++kk) qf[kk] = *(const bf16x8*)(proj + qtok * 1280 + head * 64 + kk * 16 + 8 * h);
      f32x16 s[5];
#pragma unroll
      for (int t = 0; t < 5; ++t) {
#pragma unroll
        for (int i = 0; i < 16; ++i) s[t][i] = 0.f;
        const char* kp = sK + (32 * (sb + t) + l31) * 128;
#pragma unroll
        for (int kk = 0; kk < 4; ++kk) { const bf16x8 kf = *(const bf16x8*)(kp + (((kk * 2 + h) ^ swz) << 4)); s[t] = MFMA(kf, qf[kk], s[t]); }
      }
      const float sink = sinks[head];
      float mx = sink;
#pragma unroll
      for (int t = 0; t < 5; ++t)
#pragma unroll
        for (int i = 0; i < 16; ++i) {
          const float pen = (nb > 0 || sb + t >= 4) ? 0.f : -1e30f;
          float sv = s[t][i] * 0.125f + pen;
          if (t == 0) sv = (crow(i, h) > l31) ? sv : -1e30f;
          if (t == 4) sv = (crow(i, h) <= l31) ? sv : -1e30f;
          s[t][i] = sv; mx = fmaxf(mx, sv);
        }
      mx = fmaxf(mx, __shfl_xor(mx, 32));
      float sum = 0.f;
#pragma unroll
      for (int t = 0; t < 5; ++t)
#pragma unroll
        for (int i = 0; i < 16; ++i) { const float pv = __expf(s[t][i] - mx); s[t][i] = pv; sum += pv; }
      sum += __shfl_xor(sum, 32);
      sum += __expf(sink - mx);
      f32x16 o[2];
#pragma unroll
      for (int mi = 0; mi < 2; ++mi)
#pragma unroll
        for (int i = 0; i < 16; ++i) o[mi][i] = 0.f;
#pragma unroll
      for (int t = 0; t < 5; ++t)
#pragma unroll
        for (int s2 = 0; s2 < 2; ++s2) {
          u32x4 pp;
#pragma unroll
          for (int e = 0; e < 4; ++e) pp[e] = pk2(s[t][8 * s2 + 2 * e], s[t][8 * s2 + 2 * e + 1]);
          const bf16x8 pf = __builtin_bit_cast(bf16x8, pp);
#pragma unroll
          for (int mi = 0; mi < 2; ++mi) {
            const char* vp = sVt + (mi * 32 + l31) * 520 + (32 * (sb + t) + 16 * s2 + 4 * h) * 2;
            const s16x4 lo = *(const s16x4*)vp; const s16x4 hi = *(const s16x4*)(vp + 16);
            const bf16x8 vf = __builtin_shufflevector(lo, hi, 0, 1, 2, 3, 4, 5, 6, 7);
            o[mi] = MFMA(vf, pf, o[mi]);
          }
        }
      const float inv = 1.f / sum;
#pragma unroll
      for (int mi = 0; mi < 2; ++mi)
#pragma unroll
        for (int gi = 0; gi < 4; ++gi) {
          u32x2 ov; ov[0] = pk2(o[mi][4 * gi] * inv, o[mi][4 * gi + 1] * inv); ov[1] = pk2(o[mi][4 * gi + 2] * inv, o[mi][4 * gi + 3] * inv);
          *(u32x2*)(cat + qtok * 1024 + head * 64 + mi * 32 + 8 * gi + 4 * h) = ov;
        }
    }
    __syncthreads();
  }
}

template <int W, int UB>
DI void pool_fill(const bf16_t* proj, const bf16_t* Wp, char* sD, char* sW, int tid, int t0, int tin0, int g) {
#pragma unroll 1
  for (int jb = 0; jb < 4; jb += UB) {
    u32x4 cu[UB], rr[UB][W - 1], wv[UB];
#pragma unroll
    for (int u = 0; u < UB; ++u) {
      const int q = tid + 512 * (jb + u), tok = q >> 4, c = q & 15, tin = tin0 + tok;
      const bf16_t* pp = proj + (size_t)(t0 + tok) * 1280 + 768 + g * 128 + c * 8;
      cu[u] = *(const u32x4*)pp;
#pragma unroll
      for (int i = 1; i < W; ++i) rr[u][i - 1] = *(const u32x4*)(pp - (size_t)((i <= tin) ? i : 0) * 1280);
      wv[u] = *(const u32x4*)(Wp + (size_t)g * 16384 + tok * 128 + c * 8);
    }
#pragma unroll
    for (int u = 0; u < UB; ++u) {
      const int q = tid + 512 * (jb + u), tok = q >> 4, c = q & 15, tin = tin0 + tok;
      float cur[8], sum[8], d[8];
      unpack8(cu[u], cur);
#pragma unroll
      for (int e = 0; e < 8; ++e) sum[e] = cur[e];
#pragma unroll
      for (int i = 1; i < W; ++i) {
        float f[8]; unpack8(rr[u][i - 1], f);
        const float m = (i <= tin) ? 1.f : 0.f;
#pragma unroll
        for (int e = 0; e < 8; ++e) sum[e] += m * f[e];
      }
      const int cnt = (tin + 1 < W) ? (tin + 1) : W;
      const float ic = 1.f / (float)cnt;
#pragma unroll
      for (int e = 0; e < 8; ++e) d[e] = sum[e] * ic - cur[e];
      *(u32x4*)(sD + swz128(tok, c)) = pack8(d);
      *(u32x4*)(sW + swz128(tok, c)) = wv[u];
    }
  }
}
DI void pool_phase(const bf16_t* proj, bf16_t* cat, const bf16_t* Wp, const float* scale, char* lds) {
  char* sD = lds; char* sW = lds + 32768;
  const int tid = otid(), lane = tid & 63, wave = tid >> 6, h = lane >> 5, l31 = lane & 31;
  for (int item = blockIdx.x; item < 512; item += gridDim.x) {
    const int g = item & 3, tt = item >> 2, t0 = tt * 128, tin0 = t0 & (SEQ - 1);
    if (g == 0) pool_fill<2, 4>(proj, Wp, sD, sW, tid, t0, tin0, g); else if (g == 1) pool_fill<4, 4>(proj, Wp, sD, sW, tid, t0, tin0, g);
    else if (g == 2) pool_fill<8, 2>(proj, Wp, sD, sW, tid, t0, tin0, g); else pool_fill<16, 1>(proj, Wp, sD, sW, tid, t0, tin0, g);
    __syncthreads();
    const int tk = wave & 3, dt0 = (wave >> 2) * 2;
    f32x16 acc[2];
#pragma unroll
    for (int e = 0; e < 2; ++e)
#pragma unroll
      for (int i = 0; i < 16; ++i) acc[e][i] = 0.f;
#pragma unroll
    for (int kk = 0; kk < 8; ++kk) {
      const bf16x8 yf = *(const bf16x8*)(sD + swz128(32 * tk + l31, 2 * kk + h));
#pragma unroll
      for (int e = 0; e < 2; ++e) {
        const bf16x8 xf = *(const bf16x8*)(sW + swz128(32 * (dt0 + e) + l31, 2 * kk + h));
        acc[e] = MFMA(xf, yf, acc[e]);
      }
    }
    const size_t tok = (size_t)t0 + 32 * tk + l31;
#pragma unroll
    for (int e = 0; e < 2; ++e)
#pragma unroll
      for (int gi = 0; gi < 4; ++gi) {
        const int dout = 32 * (dt0 + e) + 8 * gi + 4 * h;
        const f32x4 sc = *(const f32x4*)(scale + g * 128 + dout);
        u32x2 ov; ov[0] = pk2(acc[e][4 * gi] * sc[0], acc[e][4 * gi + 1] * sc[1]); ov[1] = pk2(acc[e][4 * gi + 2] * sc[2], acc[e][4 * gi + 3] * sc[3]);
        *(u32x2*)(cat + tok * 1024 + 512 + g * 128 + dout) = ov;
      }
    LDS_BARRIER();
  }
}

DI void conv8(const bf16_t* P, size_t tok, int tin, int col, const float* cw, const float* cb, float (&out)[8]) {
  float a[8];
  { const f32x4 b0 = *(const f32x4*)(cb + col), b1 = *(const f32x4*)(cb + col + 4);
    a[0] = b0[0]; a[1] = b0[1]; a[2] = b0[2]; a[3] = b0[3]; a[4] = b1[0]; a[5] = b1[1]; a[6] = b1[2]; a[7] = b1[3]; }
  u32x4 raw[4];
#pragma unroll
  for (int kk = 0; kk < 4; ++kk) raw[kk] = *(const u32x4*)(P + (tok - ((tin - 3 + kk >= 0) ? (3 - kk) : 0)) * 5120 + 2048 + col);
#pragma unroll
  for (int kk = 0; kk < 4; ++kk) {
    float f[8]; unpack8(raw[kk], f);
    const float ok = (tin - 3 + kk >= 0) ? 1.f : 0.f;
    const f32x4 w0 = *(const f32x4*)(cw + kk * 3072 + col) * ok, w1 = *(const f32x4*)(cw + kk * 3072 + col + 4) * ok;
    a[0] += w0[0] * f[0]; a[1] += w0[1] * f[1]; a[2] += w0[2] * f[2]; a[3] += w0[3] * f[3];
    a[4] += w1[0] * f[4]; a[5] += w1[1] * f[5]; a[6] += w1[2] * f[6]; a[7] += w1[3] * f[7];
  }
#pragma unroll
  for (int e = 0; e < 8; ++e) out[e] = silu(a[e]);
}

DI void ssd_cb_phase(const bf16_t* P, bf16_t* BT, bf16_t* Cc, bf16_t* CB, const float* dt, float* acs,
                     const float* cw, const float* cb, const float* A_log, char* lds) {
  char* sB = lds; char* sC = lds + 32768;
  const int tid = otid(), lane = tid & 63, wave = tid >> 6, h = lane >> 5, l31 = lane & 31;
  for (int item = blockIdx.x; item < 512; item += gridDim.x) {
    const int g = item & 3, c = (item >> 2) & 63, b = item >> 8;
    const size_t t0 = (size_t)b * SEQ + c * 128;
    const int tin0 = c * 128;
    bf16_t* BTi = BT + (size_t)item * 16384; bf16_t* Cci = Cc + (size_t)item * 16384; bf16_t* CBi = CB + (size_t)item * 16384;
    float* sW = (float*)(lds + 65536);
    u32x4 raw[4][4];
#pragma unroll
    for (int j = 0; j < 4; ++j) {
      const int q = tid + 512 * j;
      const int lb = q & 127, cb8 = q >> 7;
#pragma unroll
      for (int kk = 0; kk < 4; ++kk) raw[j][kk] = *(const u32x4*)(P + (t0 + lb - ((tin0 + lb - 3 + kk >= 0) ? (3 - kk) : 0)) * 5120 + 2048 + 2048 + g * 128 + cb8 * 8);
    }
    for (int q = tid; q < 1280; q += 512) { const int which = q / 640, r = q % 640, kk = r >> 7, col = 2048 + which * 512 + g * 128 + (r & 127); sW[q] = (kk < 4) ? cw[kk * 3072 + col] : cb[col]; }
    LDS_BARRIER();
#pragma unroll
    for (int j = 0; j < 4; ++j) {
      const int q = tid + 512 * j, l = q & 127, cch = q >> 7;
      float v[8];
      { const f32x4 b0 = *(const f32x4*)(sW + 512 + cch * 8), b1 = *(const f32x4*)(sW + 512 + cch * 8 + 4);
        v[0] = b0[0]; v[1] = b0[1]; v[2] = b0[2]; v[3] = b0[3]; v[4] = b1[0]; v[5] = b1[1]; v[6] = b1[2]; v[7] = b1[3]; }
#pragma unroll
      for (int kk = 0; kk < 4; ++kk) {
        float f[8]; unpack8(raw[j][kk], f);
        const float ok = (tin0 + l - 3 + kk >= 0) ? 1.f : 0.f;
        const f32x4 w0 = *(const f32x4*)(sW + kk * 128 + cch * 8) * ok, w1 = *(const f32x4*)(sW + kk * 128 + cch * 8 + 4) * ok;
        v[0] += w0[0] * f[0]; v[1] += w0[1] * f[1]; v[2] += w0[2] * f[2]; v[3] += w0[3] * f[3];
        v[4] += w1[0] * f[4]; v[5] += w1[1] * f[5]; v[6] += w1[2] * f[6]; v[7] += w1[3] * f[7];
      }
#pragma unroll
      for (int e = 0; e < 8; ++e) v[e] = silu(v[e]);
      const u32x4 pk = pack8(v);
      *(u32x4*)(sB + swz128(l, cch)) = pk;
#pragma unroll
      for (int e = 0; e < 8; ++e) BTi[(cch * 8 + e) * 128 + l] = (bf16_t)(pk[e >> 1] >> (16 * (e & 1)));
      { const int lc = q >> 4, cc8 = q & 15;
#pragma unroll
        for (int kk = 0; kk < 4; ++kk) raw[j][kk] = *(const u32x4*)(P + (t0 + lc - ((tin0 + lc - 3 + kk >= 0) ? (3 - kk) : 0)) * 5120 + 2048 + 2560 + g * 128 + cc8 * 8); }
    }
#pragma unroll
    for (int j = 0; j < 4; ++j) {
      const int q = tid + 512 * j, l = q >> 4, cch = q & 15;
      float v[8];
      { const f32x4 b0 = *(const f32x4*)(sW + 640 + 512 + cch * 8), b1 = *(const f32x4*)(sW + 640 + 512 + cch * 8 + 4);
        v[0] = b0[0]; v[1] = b0[1]; v[2] = b0[2]; v[3] = b0[3]; v[4] = b1[0]; v[5] = b1[1]; v[6] = b1[2]; v[7] = b1[3]; }
#pragma unroll
      for (int kk = 0; kk < 4; ++kk) {
        float f[8]; unpack8(raw[j][kk], f);
        const float ok = (tin0 + l - 3 + kk >= 0) ? 1.f : 0.f;
        const f32x4 w0 = *(const f32x4*)(sW + 640 + kk * 128 + cch * 8) * ok, w1 = *(const f32x4*)(sW + 640 + kk * 128 + cch * 8 + 4) * ok;
        v[0] += w0[0] * f[0]; v[1] += w0[1] * f[1]; v[2] += w0[2] * f[2]; v[3] += w0[3] * f[3];
        v[4] += w1[0] * f[4]; v[5] += w1[1] * f[5]; v[6] += w1[2] * f[6]; v[7] += w1[3] * f[7];
      }
#pragma unroll
      for (int e = 0; e < 8; ++e) v[e] = silu(v[e]);
      const u32x4 pk = pack8(v);
      *(u32x4*)(sC + swz128(l, cch)) = pk;
      *(u32x4*)(Cci + l * 128 + cch * 8) = pk;
    }
    {
      const int hh = 8 * g + wave;
      const float Ah = -__expf(A_log[hh]);
      const int l0 = 2 * lane;
      const float d0 = dt[(t0 + l0) * 32 + hh] * Ah, d1 = dt[(t0 + l0 + 1) * 32 + hh] * Ah;
      float sc = d0 + d1;
#pragma unroll
      for (int o = 1; o < 64; o <<= 1) { const float v = __shfl_up(sc, o); if (lane >= o) sc += v; }
      acs[(t0 + l0) * 32 + hh] = sc - d1;
      acs[(t0 + l0 + 1) * 32 + hh] = sc;
    }
    LDS_BARRIER();
    const int lt = wave & 3, st0 = (wave >> 2) * 2;
    f32x16 acc[2];
#pragma unroll
    for (int e = 0; e < 2; ++e)
#pragma unroll
      for (int i = 0; i < 16; ++i) acc[e][i] = 0.f;
#pragma unroll
    for (int kk = 0; kk < 8; ++kk) {
      const bf16x8 yf = *(const bf16x8*)(sC + swz128(32 * lt + l31, 2 * kk + h));
#pragma unroll
      for (int e = 0; e < 2; ++e) {
        const bf16x8 xf = *(const bf16x8*)(sB + swz128(32 * (st0 + e) + l31, 2 * kk + h));
        acc[e] = MFMA(xf, yf, acc[e]);
      }
    }
    const int l = 32 * lt + l31;
#pragma unroll
    for (int e = 0; e < 2; ++e)
#pragma unroll
      for (int gi = 0; gi < 4; ++gi) {
        const int s = 32 * (st0 + e) + 8 * gi + 4 * h;
        u32x2 ov; ov[0] = pk2(acc[e][4 * gi], acc[e][4 * gi + 1]); ov[1] = pk2(acc[e][4 * gi + 2], acc[e][4 * gi + 3]);
        *(u32x2*)(CBi + l * 128 + s) = ov;
      }
    LDS_BARRIER();
  }
}

DI void ssd_scan_phase(bf16_t* P, const bf16_t* BT, const bf16_t* Cc, const bf16_t* CB, const float* dt, const float* acs,
                       const float* cw, const float* cb, const float* Dp, char* lds, bool dry, int mode, float* Sbuf) {
  char* sCBL = lds; char* sC = lds + 32768; char* sBT = lds + 65536; char* sXdt = lds + 98304; char* sXds = lds + 106496;
  char* sSt = lds + 114688;
  char* sXs = lds + 131072;
  float* sAcs = (float*)(lds + 141312);
  float* sDt = (float*)(lds + 142336);
  float* sCw = (float*)(lds + 143360);
  const int tid = otid(), lane = tid & 63, wave = tid >> 6, h = lane >> 5, l31 = lane & 31;
  const int r0_ = tid >> 4, cch_ = tid & 15, r0 = r0_, cch = cch_;
  const int xl_ = 2 * ((tid - 256) & 63), xc_ = (tid - 256) >> 6, xl = xl_, xc = xc_;
  for (int item0 = blockIdx.x; item0 < 256; item0 += gridDim.x) {
    const int item = item0 & 127, seg = item0 >> 7, c0 = mode ? seg * 16 : seg * 32, c1 = c0 + (mode ? 16 : 32);
    const bool zero_init = (mode == 1) || (seg == 0);
    const int grp = item & 7, mem = (item >> 3) & 15, b = grp >> 2, g = grp & 3, hh = 8 * g + (mem >> 1), ph = mem & 1;
    const int pcol = hh * 64 + ph * 32;
    const float Dh = Dp[hh];
    f32x16 st;
#pragma unroll
    for (int i = 0; i < 16; ++i) st[i] = 0.f;
    if (zero_init) { for (int q = tid; q < 2048; q += 512) ((unsigned*)sSt)[q] = 0u; }
    else if (wave >= 4) {
      float dsum = 0.f;
      for (int cc = 16; cc < 32; ++cc) dsum += acs[((size_t)b * SEQ + cc * 128 + 127) * 32 + hh];
      const float Db = __expf(dsum);
      const float* spa = Sbuf + ((size_t)item * 4 + (wave - 4)) * 1024 + lane * 16;
      const float* spb = spa + (size_t)128 * 4 * 1024;
#pragma unroll
      for (int gi = 0; gi < 4; ++gi) { const f32x4 va = *(const f32x4*)(spa + 4 * gi), vb = *(const f32x4*)(spb + 4 * gi); const f32x4 v = va * Db + vb;
        st[4 * gi] = v[0]; st[4 * gi + 1] = v[1]; st[4 * gi + 2] = v[2]; st[4 * gi + 3] = v[3];
        u32x2 ov; ov[0] = pk2(v[0], v[1]); ov[1] = pk2(v[2], v[3]);
        *(u32x2*)(sSt + l31 * 256 + (((4 * (wave - 4) + gi) ^ (l31 & 15)) << 4) + 8 * h) = ov; }
    }
    if (tid < 160) sCw[tid] = (tid < 128) ? cw[(tid >> 5) * 3072 + pcol + (tid & 31)] : cb[pcol + tid - 128];
    const size_t tb = (size_t)b * SEQ, tbs = tb + (size_t)c0 * 128;
    const size_t cbi0 = ((size_t)(b * 64) * 4 + g) * 16384;
    const unsigned toff = r0 * 128 + cch * 8;
    const unsigned xoff = xl * 5120 + xc * 8;
    const unsigned zoff = (32 * (wave & 3) + l31) * 5120 + 4 * h;
    u32x4 rC[4], rB[4], rCB[4], rX[5];
    u32x2 cz[4];
    float racs = 0.f, rdt = 0.f;
    unsigned tchA = 0u, tchB = 0u, tsum = 0u;
    {
      const size_t cbis = cbi0 + (size_t)c0 * 65536;
      const bf16_t* Cq = Cc + cbis; const bf16_t* Bq = BT + cbis; const bf16_t* CBq = CB + cbis;
#pragma unroll
      for (int j = 0; j < 4; ++j) { rB[j] = *(const u32x4*)(Bq + toff + j * 4096); rC[j] = (u32x4){0u, 0u, 0u, 0u}; rCB[j] = (u32x4){0u, 0u, 0u, 0u};
        if (mode == 0) { rC[j] = *(const u32x4*)(Cq + toff + j * 4096); rCB[j] = *(const u32x4*)(CBq + toff + j * 4096); } }
      const bf16_t* Xq = P + tbs * 5120 + 2048 + pcol;
#pragma unroll
      for (int kk = 0; kk < 5; ++kk) {
        rX[kk] = (u32x4){0u, 0u, 0u, 0u};
        if (wave >= 4 && (c0 > 0 || xl - 3 + kk >= 0)) rX[kk] = *(const u32x4*)(Xq + (xl - 3 + kk) * 5120 + xc * 8);
      }
      const bf16_t* Zq = P + tbs * 5120 + pcol;
#pragma unroll
      for (int gi = 0; gi < 4; ++gi) cz[gi] = (u32x2){0u, 0u};
      if (wave < 4 && mode == 0) {
#pragma unroll
        for (int gi = 0; gi < 4; ++gi) cz[gi] = *(const u32x2*)(Zq + zoff + 8 * gi);
      }
      const float* aq = acs + tbs * 32 + hh; const float* dq = dt + tbs * 32 + hh;
      if (tid < 128) { sAcs[tid] = aq[tid * 32]; sDt[tid] = dq[tid * 32]; racs = aq[4096 + tid * 32]; rdt = dq[4096 + tid * 32]; }
    }
    __syncthreads();
#pragma unroll 1
    for (int c = c0; c < c1; ++c) {
      const size_t t0 = tb + c * 128;
      const float* cAcs = sAcs + (c & 1) * 128; const float* cDt = sDt + (c & 1) * 128;
      {
        int xl = xl_, xc = xc_, r0 = r0_, cch = cch_;
        asm volatile("" : "+v"(xl), "+v"(xc), "+v"(r0), "+v"(cch));
        const f32x4 a0 = *(const f32x4*)(cAcs + cch * 8), a1 = *(const f32x4*)(cAcs + cch * 8 + 4);
        const float L2E = 1.44269504f;
        const float as[8] = {a0[0] * L2E, a0[1] * L2E, a0[2] * L2E, a0[3] * L2E, a1[0] * L2E, a1[1] * L2E, a1[2] * L2E, a1[3] * L2E};
#pragma unroll
        for (int j = 0; j < 4; ++j) {
          const int r = r0 + 32 * j;
          *(u32x4*)(sBT + swz128(r, cch)) = rB[j];
          if (mode == 0) {
            *(u32x4*)(sC + swz128(r, cch)) = rC[j];
            float f[8]; unpack8(rCB[j], f);
            const float el = cAcs[r] * L2E;
            const int lim = r - cch * 8;
#pragma unroll
            for (int e = 0; e < 8; ++e) f[e] = (e <= lim) ? f[e] * __builtin_amdgcn_exp2f(el - as[e]) : 0.f;
            *(u32x4*)(sCBL + swz128(r, cch)) = pack8(f);
          }
        }
        if (wave >= 4) {
          float a[8], bq[8];
          { const f32x4 b0 = *(const f32x4*)(sCw + 128 + xc * 8), b1 = *(const f32x4*)(sCw + 128 + xc * 8 + 4);
            a[0] = b0[0]; a[1] = b0[1]; a[2] = b0[2]; a[3] = b0[3]; a[4] = b1[0]; a[5] = b1[1]; a[6] = b1[2]; a[7] = b1[3]; }
#pragma unroll
          for (int e = 0; e < 8; ++e) bq[e] = a[e];
#pragma unroll
          for (int kk = 0; kk < 4; ++kk) {
            float f[8], f2[8]; unpack8(rX[kk], f); unpack8(rX[kk + 1], f2);
            const f32x4 w0 = *(const f32x4*)(sCw + kk * 32 + xc * 8), w1 = *(const f32x4*)(sCw + kk * 32 + xc * 8 + 4);
            a[0] += w0[0] * f[0]; a[1] += w0[1] * f[1]; a[2] += w0[2] * f[2]; a[3] += w0[3] * f[3];
            a[4] += w1[0] * f[4]; a[5] += w1[1] * f[5]; a[6] += w1[2] * f[6]; a[7] += w1[3] * f[7];
            bq[0] += w0[0] * f2[0]; bq[1] += w0[1] * f2[1]; bq[2] += w0[2] * f2[2]; bq[3] += w0[3] * f2[3];
            bq[4] += w1[0] * f2[4]; bq[5] += w1[1] * f2[5]; bq[6] += w1[2] * f2[6]; bq[7] += w1[3] * f2[7];
          }
#pragma unroll
          for (int e = 0; e < 8; ++e) { a[e] = silu(a[e]); bq[e] = silu(bq[e]); }
          if (mode == 0) { *(u32x4*)(sXs + xl * 80 + xc * 16) = pack8(a); *(u32x4*)(sXs + (xl + 1) * 80 + xc * 16) = pack8(bq); }
          const float e127 = cAcs[127];
          const float dlA = cDt[xl], dlB = cDt[xl + 1];
          const float dsA = dlA * __expf(e127 - cAcs[xl]), dsB = dlB * __expf(e127 - cAcs[xl + 1]);
#pragma unroll
          for (int e = 0; e < 8; ++e) {
            const int pr = xc * 8 + e;
            const int off = pr * 256 + (((xl >> 3) ^ (pr & 15)) << 4) + (xl & 7) * 2;
            if (mode == 0) *(unsigned*)(sXdt + off) = pk2(a[e] * dlA, bq[e] * dlB);
            *(unsigned*)(sXds + off) = pk2(a[e] * dsA, bq[e] * dsB);
          }
        }
      }
      float nacs = 0.f, ndt = 0.f;
      tsum += tchA + tchB;
      if (c + 2 < c1) {
        const size_t cb2 = cbi0 + (size_t)(c + 2) * 65536;
        const int tl = tid & 255;
        if (mode == 0 || tid >= 256) tchA = *(const unsigned*)((tid < 256 ? Cc : BT) + cb2 + tl * 64);
        const bf16_t* rowp = P + (t0 + 256 + (tid & 127)) * 5120 + pcol + ((tid < 384) ? 2048 : 0);
        if (mode == 0 || (tid >= 256 && tid < 384)) tchB = *(const unsigned*)((tid < 256) ? (CB + cb2 + tl * 64) : rowp);
      }
      if (c + 1 < c1) {
        if (c + 2 < c1 && tid < 128) { nacs = (acs + (t0 + 256) * 32 + hh)[tid * 32]; ndt = (dt + (t0 + 256) * 32 + hh)[tid * 32]; }
        const size_t cbi = cbi0 + (size_t)(c + 1) * 65536;
        const bf16_t* Cq = Cc + cbi; const bf16_t* Bq = BT + cbi; const bf16_t* CBq = CB + cbi;
#pragma unroll
        for (int j = 0; j < 4; ++j) { rB[j] = *(const u32x4*)(Bq + toff + j * 4096); if (mode == 0) { rC[j] = *(const u32x4*)(Cq + toff + j * 4096); rCB[j] = *(const u32x4*)(CBq + toff + j * 4096); } }
        const bf16_t* Xq = P + (t0 + 125) * 5120 + 2048 + pcol;
#pragma unroll
        for (int kk = 0; kk < 5; ++kk) { if (wave >= 4) rX[kk] = *(const u32x4*)(Xq + xoff + kk * 5120); }
      }
      __builtin_amdgcn_sched_barrier(0);
      LDS_BARRIER();
      int lq = l31, hq = h;
      asm volatile("" : "+v"(lq), "+v"(hq));
      if (wave < 4) {
       if (mode == 0) {
        const int lt = wave;
        f32x16 ad, ao;
#pragma unroll
        for (int i = 0; i < 16; ++i) { ad[i] = 0.f; ao[i] = 0.f; }
        const char* stb = sSt + (c & 1) * 8192;
#pragma unroll
        for (int kk = 0; kk < 8; ++kk) {
          const bf16x8 yf = *(const bf16x8*)(sCBL + swz128(32 * lt + lq, 2 * kk + hq));
          const bf16x8 xf = *(const bf16x8*)(sXdt + swz128(lq, 2 * kk + hq));
          ad = MFMA(xf, yf, ad);
          const bf16x8 yf2 = *(const bf16x8*)(sC + swz128(32 * lt + lq, 2 * kk + hq));
          const bf16x8 xf2 = *(const bf16x8*)(stb + swz128(lq, 2 * kk + hq));
          ao = MFMA(xf2, yf2, ao);
        }
        const int l = 32 * lt + l31;
        const float eo = __expf(cAcs[l]);
        bf16_t* Zq = P + t0 * 5120 + pcol;
#pragma unroll
        for (int gi = 0; gi < 4; ++gi) {
          const int p0 = 8 * gi + 4 * h;
          const u32x2 xsv = *(const u32x2*)(sXs + l * 80 + p0 * 2);
          const u32x2 zv = cz[gi];
          const float xs0 = bflo(xsv[0]), xs1 = bfhi(xsv[0]), xs2 = bflo(xsv[1]), xs3 = bfhi(xsv[1]);
          const float z0 = bflo(zv[0]), z1 = bfhi(zv[0]), z2 = bflo(zv[1]), z3 = bfhi(zv[1]);
          const float y0 = (ad[4 * gi] + eo * ao[4 * gi] + Dh * xs0) * silu(z0);
          const float y1 = (ad[4 * gi + 1] + eo * ao[4 * gi + 1] + Dh * xs1) * silu(z1);
          const float y2 = (ad[4 * gi + 2] + eo * ao[4 * gi + 2] + Dh * xs2) * silu(z2);
          const float y3 = (ad[4 * gi + 3] + eo * ao[4 * gi + 3] + Dh * xs3) * silu(z3);
          u32x2 ov; ov[0] = pk2(y0, y1); ov[1] = pk2(y2, y3);
          if (!dry) *(u32x2*)(Zq + zoff + 8 * gi) = ov;
        }
        if (c + 1 < c1) {
#pragma unroll
          for (int gi = 0; gi < 4; ++gi) cz[gi] = *(const u32x2*)(Zq + 128 * 5120 + zoff + 8 * gi);
        }
       }
      } else {
        const int nt = wave - 4;
        const float dec = __expf(cAcs[127]);
#pragma unroll
        for (int i = 0; i < 16; ++i) st[i] *= dec;
#pragma unroll
        for (int kk = 0; kk < 8; ++kk) {
          const bf16x8 xf = *(const bf16x8*)(sBT + swz128(32 * nt + lq, 2 * kk + hq));
          const bf16x8 yf = *(const bf16x8*)(sXds + swz128(lq, 2 * kk + hq));
          st = MFMA(xf, yf, st);
        }
        char* stn = sSt + ((c + 1) & 1) * 8192;
#pragma unroll
        for (int gi = 0; gi < 4; ++gi) {
          u32x2 ov; ov[0] = pk2(st[4 * gi], st[4 * gi + 1]); ov[1] = pk2(st[4 * gi + 2], st[4 * gi + 3]);
          *(u32x2*)(stn + l31 * 256 + (((4 * nt + gi) ^ (l31 & 15)) << 4) + 8 * h) = ov;
        }
      }
      if (tid < 128) { sAcs[((c + 1) & 1) * 128 + tid] = racs; sDt[((c + 1) & 1) * 128 + tid] = rdt; }
      racs = nacs; rdt = ndt;
      LDS_BARRIER();
    }
    if (mode == 1 && wave >= 4) {
      float* sp = Sbuf + ((size_t)(seg * 128 + item) * 4 + (wave - 4)) * 1024 + lane * 16;
#pragma unroll
      for (int gi = 0; gi < 4; ++gi) { f32x4 v; v[0] = st[4 * gi]; v[1] = st[4 * gi + 1]; v[2] = st[4 * gi + 2]; v[3] = st[4 * gi + 3]; *(f32x4*)(sp + 4 * gi) = v; }
    }
    __syncthreads();
    if (tsum == 0x9e3779b9u && dry) sDt[0] = 1.f;
  }
}

DI void gnorm_phase(bf16_t* P, const float* nw, bool dry) {
  const int tid = otid(), lane = tid & 63, wave = tid >> 6;
  const int stride = gridDim.x * 8;
  for (int rg0 = blockIdx.x * 8 + wave; rg0 < T * 4; rg0 += stride * 4) {
    u32x4 r[4];
#pragma unroll
    for (int k = 0; k < 4; ++k) { const int rg = rg0 + k * stride; const int rgc = (rg < T * 4) ? rg : rg0; r[k] = *(const u32x4*)(P + (size_t)(rgc >> 2) * 5120 + (rgc & 3) * 512 + lane * 8); }
#pragma unroll
    for (int k = 0; k < 4; ++k) {
      const int rg = rg0 + k * stride;
      if (rg < T * 4) {
        const int t = rg >> 2, g = rg & 3;
        float f[8]; unpack8(r[k], f);
        float ss = 0.f;
#pragma unroll
        for (int e = 0; e < 8; ++e) ss += f[e] * f[e];
        ss = wave_sum(ss);
        const float rstd = rsqrtf(ss * (1.f / 512.f) + 1e-5f);
        const f32x4 w0 = *(const f32x4*)(nw + g * 512 + lane * 8), w1 = *(const f32x4*)(nw + g * 512 + lane * 8 + 4);
        f[0] *= rstd * w0[0]; f[1] *= rstd * w0[1]; f[2] *= rstd * w0[2]; f[3] *= rstd * w0[3];
        f[4] *= rstd * w1[0]; f[5] *= rstd * w1[1]; f[6] *= rstd * w1[2]; f[7] *= rstd * w1[3];
        if (!dry) *(u32x4*)(P + (size_t)t * 5120 + g * 512 + lane * 8) = pack8(f);
      }
    }
  }
}


#define XB_TMO      128
#define XB_XCNT(j)  (256  + 64 * (j))
#define XB_XSUB(j)  (1280 + 64 * (j))
#define XB_XGEN(j)  (2304 + 64 * (j))
#define XB_TOP      3328
#define XB_TOPGEN   3392
#define XCD_BAR_WORDS 3456
#define XB_SPIN_CAP (1u << 20)
#define LAS3 __attribute__((address_space(3)))
DI unsigned xb_ld(unsigned* p)              { return __hip_atomic_load(p, __ATOMIC_RELAXED, __HIP_MEMORY_SCOPE_AGENT); }
DI unsigned xb_add(unsigned* p, unsigned v) { return __hip_atomic_fetch_add(p, v, __ATOMIC_RELAXED, __HIP_MEMORY_SCOPE_AGENT); }
DI unsigned xb_xcc_id() { return (unsigned)__builtin_amdgcn_s_getreg((3 << 11) | 20) & 0xFu; }
#define XB_SPIN(cond, bar) do { unsigned _sp = 0; while (cond) { __builtin_amdgcn_s_sleep(1); \
    if ((++_sp & 255u) == 0u) { if (xb_ld(&(bar)[XB_TMO])) break; if (_sp > XB_SPIN_CAP) { atomicAdd(&(bar)[XB_TMO], 1u); break; } } } } while (0)
struct XcdBarrier { unsigned* bar; unsigned x; volatile LAS3 unsigned* st; };
DI XcdBarrier xcd_barrier_post(unsigned* bar, volatile LAS3 unsigned* st) {
  XcdBarrier b; b.bar = bar; b.x = xb_xcc_id(); b.st = st;
  if (threadIdx.x == 0) (void)xb_add(&bar[XB_XCNT(b.x)], 1u);
  return b;
}
DI void xcd_barrier_complete(unsigned* bar, unsigned x, unsigned& nloc, unsigned& nx) {
  const unsigned G = gridDim.x * gridDim.y * gridDim.z;
  unsigned sum, cnt, mine, sp = 0u;
  for (;;) {
    sum = 0u; cnt = 0u; mine = 0u;
#pragma unroll
    for (unsigned j = 0; j < 16; ++j) { const unsigned c = xb_ld(&bar[XB_XCNT(j)]); sum += c; cnt += (c > 0u) ? 1u : 0u; mine = (j == x) ? c : mine; }
    if (sum == G) break;
    __builtin_amdgcn_s_sleep(1);
    if ((++sp & 255u) == 0u) { if (xb_ld(&bar[XB_TMO])) break; if (sp > XB_SPIN_CAP) { atomicAdd(&bar[XB_TMO], 1u); break; } }
  }
  nloc = mine > 0u ? mine : 1u; nx = cnt > 0u ? cnt : 1u;
}
DI void xcd_barrier(const XcdBarrier& b) {
  asm volatile("s_waitcnt vmcnt(0)" ::: "memory");
  __syncthreads();
  if (threadIdx.x == 0) {
    unsigned* bar = b.bar;
    __builtin_amdgcn_s_waitcnt(0);
    unsigned nloc = b.st[0], nx = b.st[1];
    if (nloc == 0u) { xcd_barrier_complete(bar, b.x, nloc, nx); b.st[0] = nloc; b.st[1] = nx; }
    const unsigned old = xb_add(&bar[XB_XSUB(b.x)], 1u);
    const unsigned gen = old / nloc;
    if (old + 1u == (gen + 1u) * nloc) {
      __builtin_amdgcn_fence(__ATOMIC_RELEASE, "agent");
      asm volatile("s_waitcnt vmcnt(0)" ::: "memory");
      const unsigned og = xb_add(&bar[XB_TOP], 1u);
      const unsigned tg = og / nx;
      if (og + 1u == (tg + 1u) * nx) xb_add(&bar[XB_TOPGEN], 1u);
      else XB_SPIN(xb_ld(&bar[XB_TOPGEN]) == tg, bar);
      __builtin_amdgcn_fence(__ATOMIC_ACQUIRE, "agent");
      xb_add(&bar[XB_XGEN(b.x)], 1u);
      asm volatile("s_waitcnt vmcnt(0)" ::: "memory");
    } else {
      XB_SPIN(xb_ld(&bar[XB_XGEN(b.x)]) == gen, bar);
      __builtin_amdgcn_fence(__ATOMIC_ACQUIRE, "agent");
      asm volatile("s_waitcnt vmcnt(0)" ::: "memory");
    }
  }
  __syncthreads();
}

DI int phase_kind(int ph, int& L) {
  if (ph == NPH - 1) { L = 0; return 9; }
  if (ph == 0) { L = 0; return 0; }
  int sub;
  if (ph < 6) { L = 0; sub = ph; } else if (ph < 14) { L = 1; sub = ph - 5; } else if (ph < 19) { L = 2; sub = ph - 13; } else { L = 3; sub = ph - 18; }
  if (L & 1) { return (sub < 3) ? sub : (sub == 3) ? 10 : (sub < 7) ? sub - 1 : sub; }
  return (sub < 3) ? sub : ((sub == 3) ? 5 : sub + 3);
}
DI void run_phase(const Params& p, int ph, char* lds, bool dry) {
  int L;
  const int kind = phase_kind(ph, L);
  if (kind == 9) { final_norm_phase(p.S, p.final_norm_w, p.X); return; }
  const int i = L >> 1;
  const bool odd = L & 1;
  bf16_t* Wb = p.Wb;
  switch (kind) {
#if !defined(ONLY) || ((ONLY >> 0) & 1)
    case 0: {
      convert_mixer(p, 0, lds, 0);
      init_stream_phase(p.x, p.S, p.ssq);
    } break;
#endif
#if !defined(ONLY) || ((ONLY >> 1) & 1)
    case 1: {
      if (!odd) { pg8::EpiBf16 e{p.P, 1280, nullptr, nullptr, p.ssq}; gemm_run(p.S, 1024, Wb + W_IN, 1024, 1280, lds, e); }
      else { pg8::EpiBf16 e{p.P, 5120, p.dt, p.ssd_dt_bias + i * 32, p.ssq}; gemm_run(p.S, 1024, Wb + W_IN, 1024, 5376, lds, e); }
      convert_ffn(p, L, lds, idle_from(odd ? 64 * 21 : 64 * 5));
    } break;
#endif
#if !defined(ONLY) || ((ONLY >> 2) & 1)
    case 2: {
      if (!odd) {
        bf16_t* cat = p.P + (size_t)T * 1280;
        attn_phase(p.P, cat, p.ap_sinks + i * 8, lds);
        pool_phase(p.P, cat, Wb + W_POOL, p.pool_scale + i * 512, lds);
      } else {
        ssd_cb_phase(p.P, p.H, p.H + (size_t)512 * 16384, p.CB, p.dt, p.acs, p.ssd_conv_w + (size_t)i * 4 * 3072, p.ssd_conv_b + i * 3072, p.ssd_A_log + i * 32, lds);
      }
    } break;
#endif
#if !defined(ONLY) || ((ONLY >> 3) & 1)
    case 3: case 10: ssd_scan_phase(p.P, p.H, p.H + (size_t)512 * 16384, p.CB, p.dt, p.acs, p.ssd_conv_w + (size_t)i * 4 * 3072, p.ssd_conv_b + i * 3072, p.ssd_D + i * 32, lds, dry, kind == 10 ? 1 : 0, (float*)(p.bar + XCD_BAR_WORDS)); break;
#endif
#if !defined(ONLY) || ((ONLY >> 4) & 1)
    case 4: gnorm_phase(p.P, p.ssd_norm_w + i * 2048, dry); break;
#endif
#if !defined(ONLY) || ((ONLY >> 5) & 1)
    case 5: case 8: {
      pg8::EpiResid e{(kind == 5 && L == 0) ? p.x : nullptr, p.S, p.ssq, dry};
      const bf16_t* A; int lda, K; const bf16_t* Bt;
      if (kind == 8) { A = p.P; lda = 2816; K = 2816; Bt = Wb + W_DN; }
      else if (!odd) { A = p.P + (size_t)T * 1280; lda = 1024; K = 1024; Bt = Wb + W_OUT; }
      else { A = p.P; lda = 5120; K = 2048; Bt = Wb + W_OUT; }
      gemm_run(A, lda, Bt, K, 1024, lds, e);
    } break;
#endif
#if !defined(ONLY) || ((ONLY >> 7) & 1)
    case 7: { pg8::EpiSwiglu e{p.P, p.ssq}; gemm_run(p.S, 1024, Wb + W_GU, 1024, 5632, lds, e); if (L < 3) convert_mixer(p, L + 1, lds, idle_from(64 * 22)); } break;
#endif
    default: break;
  }
}

__global__ void __launch_bounds__(512) mega(Params p, int ph_lo, int ph_hi) {
  extern __shared__ __attribute__((aligned(16))) char lds[];
  volatile LAS3 unsigned* st = (volatile LAS3 unsigned*)(LAS3 char*)(lds + 144000);
  if (threadIdx.x < 4) st[threadIdx.x] = 0u;
  __syncthreads();
  XcdBarrier xb = xcd_barrier_post(p.bar, st);
  for (int ph = ph_lo; ph < ph_hi; ++ph) {
#ifdef DUPMASK
    { int L2; const int kind2 = phase_kind(ph, L2);
      if ((DUPMASK >> kind2) & 1) { run_phase(p, ph, lds, ph_lo == 0); xcd_barrier(xb); } }
#endif
    run_phase(p, ph, lds, false);
    if (ph + 1 < ph_hi) {
      if (ph_hi > 1000) cg::this_grid().sync();
      xcd_barrier(xb);
    }
  }
}

extern "C" void kernel_launch(void* const* d_in, const int* in_sizes, int n_in, void* d_out, int out_size, void* d_ws, size_t ws_size, hipStream_t stream) {
  Params p{};
  const float** f = (const float**)&p;
  for (int i = 0; i < 20; ++i) f[i] = (const float*)d_in[i];
  p.X = (float*)d_out;
  char* ws = (char*)d_ws;
  size_t off = 0;
  p.Wb = (bf16_t*)(ws + off); off += W_TOTAL * 2;
  p.H = (bf16_t*)(ws + off); off += (size_t)T * 1024 * 2;
  p.P = (bf16_t*)(ws + off); off += (size_t)T * 5120 * 2;
  p.S = (bf16_t*)(ws + off); off += (size_t)T * 1024 * 2;
  p.bar = (unsigned*)(ws + off); off += (size_t)XCD_BAR_WORDS * 4;
  off += (size_t)2 * 128 * 4 * 1024 * 4;
  { char* os = (char*)d_out; size_t oo = 0;
    p.CB = (bf16_t*)(os + oo); oo += (size_t)512 * 16384 * 2;
    p.dt = (float*)(os + oo); oo += (size_t)T * 32 * 4;
    p.acs = (float*)(os + oo); oo += (size_t)T * 32 * 4;
    p.ssq = (float*)(os + oo); oo += (size_t)T * 16 * 4; }
  static int grid = 0;
  if (!grid) {
    (void)hipFuncSetAttribute((const void*)mega, hipFuncAttributeMaxDynamicSharedMemorySize, (int)LDS_BYTES);
    int dev = 0, cus = 0, per_cu = 0;
    (void)hipGetDevice(&dev);
    (void)hipDeviceGetAttribute(&cus, hipDeviceAttributeMultiprocessorCount, dev);
    (void)hipOccupancyMaxActiveBlocksPerMultiprocessor(&per_cu, mega, 512, LDS_BYTES);
    if (per_cu < 1) per_cu = 1;
    grid = cus * per_cu;
    if (off > ws_size) fprintf(stderr, "workspace too small: need %zu have %zu\n", off, ws_size);
  }
  (void)hipMemsetAsync(p.bar, 0, (size_t)XCD_BAR_WORDS * 4, stream);
#if COOP
  int lo = 0, hi = NPH;
  void* args[] = {&p, &lo, &hi};
  hipError_t e = hipLaunchCooperativeKernel((void*)mega, dim3(grid), dim3(512), args, LDS_BYTES, stream);
  if (e != hipSuccess) fprintf(stderr, "cooperative launch failed: %s (grid %d)\n", hipGetErrorString(e), grid);
#else
  for (int ph = 0; ph < NPH; ++ph) hipLaunchKernelGGL(mega, dim3(grid), dim3(512), LDS_BYTES, stream, p, ph, ph + 1);
#endif
}
```

```cpp
#include <hip/hip_runtime.h>
#include <hip/hip_cooperative_groups.h>
#include <cstdio>
namespace cg = cooperative_groups;

#ifndef COOP
#define COOP 1
#endif

typedef unsigned short bf16_t;
typedef short bf16x8 __attribute__((ext_vector_type(8)));
typedef short s16x4 __attribute__((ext_vector_type(4)));
typedef float f32x4 __attribute__((ext_vector_type(4)));
typedef float f32x16 __attribute__((ext_vector_type(16)));
typedef unsigned u32x4 __attribute__((ext_vector_type(4)));
typedef unsigned u32x2 __attribute__((ext_vector_type(2)));
typedef __bf16 bf2_t __attribute__((ext_vector_type(2)));
typedef float f32x2 __attribute__((ext_vector_type(2)));

#define DI __device__ __forceinline__
#define MFMA(a, b, c) __builtin_amdgcn_mfma_f32_32x32x16_bf16((a), (b), (c), 0, 0, 0)

constexpr int T = 16384;
constexpr int SEQ = 8192;
constexpr int NPH = 28;
constexpr size_t LDS_BYTES = 144016;

constexpr size_t W_IN = 0, W_OUT = 5505024, W_GU = 7602176, W_DN = 13369344, W_POOL = 16252928, W_TOTAL = 16318464;

struct Params {
  const float *x, *mix_norm_w, *ap_w_in, *ap_sinks, *pool_w, *pool_scale, *ap_w_out, *ssd_w_in, *ssd_conv_w, *ssd_conv_b,
      *ssd_dt_bias, *ssd_A_log, *ssd_D, *ssd_norm_w, *ssd_w_out, *ffn_norm_w, *w_gate, *w_up, *w_down, *final_norm_w;
  float* X;
  bf16_t *Wb, *H, *P, *CB, *S;
  float *dt, *acs, *ssq;
  unsigned* bar;
};

DI unsigned pk2(float lo, float hi) { f32x2 v = {lo, hi}; bf2_t r = __builtin_convertvector(v, bf2_t); return __builtin_bit_cast(unsigned, r); }
DI float bflo(unsigned u) { return __uint_as_float(u << 16); }
DI float bfhi(unsigned u) { return __uint_as_float(u & 0xffff0000u); }
DI float silu(float x) { return x * __builtin_amdgcn_rcpf(1.f + __expf(-x)); }
DI int crow(int i, int h) { return (i & 3) + 8 * (i >> 2) + 4 * h; }
DI int otid() { int t = threadIdx.x; asm volatile("" : "+v"(t)); return t; }
DI float wave_sum(float v) {
#pragma unroll
  for (int o = 32; o >= 1; o >>= 1) v += __shfl_xor(v, o);
  return v;
}
DI void unpack8(u32x4 r, float (&f)[8]) {
#pragma unroll
  for (int e = 0; e < 4; ++e) { f[2 * e] = bflo(r[e]); f[2 * e + 1] = bfhi(r[e]); }
}
DI u32x4 pack8(const float (&f)[8]) { u32x4 r; r[0] = pk2(f[0], f[1]); r[1] = pk2(f[2], f[3]); r[2] = pk2(f[4], f[5]); r[3] = pk2(f[6], f[7]); return r; }
DI int swz64(int r, int c) { return r * 128 + ((c ^ ((r >> 1) & 7)) << 4); }
DI int swz128(int r, int c) { return r * 256 + ((c ^ (r & 15)) << 4); }

namespace pg8 {
#define PG8_LAS __attribute__((address_space(3)))
constexpr int BM = 256, BK = 64, HALF = 128, HTB = HALF * BK * 2, NXCD = 8, WGM = 8;
DI float row_rstd(const float* ssq, int row) { const f32x4* q = (const f32x4*)(ssq + (size_t)row * 16); const f32x4 a = q[0] + q[1] + q[2] + q[3]; return rsqrtf((a[0] + a[1] + a[2] + a[3]) * (1.f / 1024.f) + 1e-5f); }
DI int lds_byte(int r, int c) { const int st = (r >> 4) * 2 + (c >> 5), rr = r & 15, cc = c & 31, ob = rr * 64 + cc * 2; return st * 1024 + (ob ^ (((ob >> 9) & 1) << 5)); }
DI void stage_rc(int b, int& R, int& C) { const int st = b / 1024, sb = b % 1024, swz = sb ^ (((sb >> 9) & 1) << 5); R = (st >> 1) * 16 + swz / 64; C = (st & 1) * 32 + (swz % 64) / 2; }
DI int perm32(int rho) { const int n = rho >> 4, i = rho & 15; return 8 * (i >> 2) + 4 * n + (i & 3); }
struct Unit { int pm, pn; };
struct Gemm { const bf16_t* A; const bf16_t* Bt; int lda, N, K; };
struct StaticOrder {
  int nM, nN, nwg, G, c;
  DI void init(int M, int N, int G_, int c_) { nM = M / BM; nN = N / BM; nwg = nM * nN; G = G_; c = c_; }
  DI bool next(int i, Unit& u) const {
    const long L = (long)i * G + c; if (L >= nwg) return false;
    int wgid = (int)L; { const int q = nwg / NXCD, r = nwg % NXCD, xcd = wgid % NXCD, off = wgid / NXCD; wgid = (xcd < r ? xcd * (q + 1) : r * (q + 1) + (xcd - r) * q) + off; }
    const int nig = WGM * nN, gid = wgid / nig, fm = gid * WGM, gsz = (nM - fm) < WGM ? (nM - fm) : WGM;
    u.pm = fm + ((wgid % nig) % gsz); u.pn = (wgid % nig) / gsz; return true;
  }
};
struct EpiBf16 {
  static constexpr bool PERM = true, RSTD = true;
  bf16_t* C; int ldc; float* dt; const float* bias; const float* ssq;
  DI void operator()(const f32x4 (&acc)[2][2][4][2], const Unit& u, int wr, int wc, int fr, int fq, const PG8_LAS float* sR) const {
    const int row0 = u.pm * BM + wr * 64 + fr;
    if (dt != nullptr && u.pn == 20) {
      if (wc == 0) {
        const f32x4 b0 = *(const f32x4*)(bias + 8 * fq), b1 = *(const f32x4*)(bias + 8 * fq + 4);
#pragma unroll
        for (int ai = 0; ai < 2; ++ai)
#pragma unroll
          for (int m = 0; m < 4; ++m) {
            f32x4 o0, o1;
            const float rs = sR[ai * 128 + m * 16 + fr];
#pragma unroll
            for (int e = 0; e < 4; ++e) {
              const float v0 = acc[ai][0][m][0][e] * rs + b0[e], v1 = acc[ai][0][m][1][e] * rs + b1[e];
              o0[e] = fmaxf(v0, 0.f) + log1pf(__expf(-fabsf(v0))); o1[e] = fmaxf(v1, 0.f) + log1pf(__expf(-fabsf(v1)));
            }
            float* dp = dt + (size_t)(row0 + ai * HALF + m * 16) * 32 + 8 * fq;
            *(f32x4*)dp = o0; *(f32x4*)(dp + 4) = o1;
          }
      }
      return;
    }
    const int col0 = u.pn * BM + wc * 32 + 8 * fq;
#pragma unroll
    for (int ai = 0; ai < 2; ++ai)
#pragma unroll
      for (int m = 0; m < 4; ++m) {
        bf16_t* rowp = C + (size_t)(row0 + ai * HALF + m * 16) * ldc + col0;
        const float rs = sR[ai * 128 + m * 16 + fr];
#pragma unroll
        for (int bj = 0; bj < 2; ++bj) {
          const f32x4 v0 = acc[ai][bj][m][0] * rs, v1 = acc[ai][bj][m][1] * rs;
          u32x4 w; w[0] = pk2(v0[0], v0[1]); w[1] = pk2(v0[2], v0[3]); w[2] = pk2(v1[0], v1[1]); w[3] = pk2(v1[2], v1[3]);
          *(u32x4*)(rowp + bj * HALF) = w;
        }
      }
  }
};
struct EpiResid {
  static constexpr bool PERM = false, RSTD = false;
  const float* X0; bf16_t* S; float* ssq; bool dry;
  DI void operator()(const f32x4 (&acc)[2][2][4][2], const Unit& u, int wr, int wc, int fr, int fq, const PG8_LAS float* sR) const {
    const int row0 = u.pm * BM + wr * 64 + fr, col0 = u.pn * BM + wc * 32 + 4 * fq;
#pragma unroll
    for (int ai = 0; ai < 2; ++ai) {
      u32x2 sv[4][2][2];
      if (X0 == nullptr) {
#pragma unroll
        for (int m = 0; m < 4; ++m)
#pragma unroll
          for (int bj = 0; bj < 2; ++bj)
#pragma unroll
            for (int n = 0; n < 2; ++n) sv[m][bj][n] = *(const u32x2*)(S + (size_t)(row0 + ai * HALF + m * 16) * 1024 + col0 + bj * HALF + n * 16);
      } else {
#pragma unroll
        for (int m = 0; m < 4; ++m)
#pragma unroll
          for (int bj = 0; bj < 2; ++bj)
#pragma unroll
            for (int n = 0; n < 2; ++n) sv[m][bj][n] = (u32x2){0u, 0u};
      }
#pragma unroll
      for (int m = 0; m < 4; ++m) {
        const int row = row0 + ai * HALF + m * 16;
        const size_t ro = (size_t)row * 1024 + col0;
        float ss = 0.f;
#pragma unroll
        for (int bj = 0; bj < 2; ++bj)
#pragma unroll
          for (int n = 0; n < 2; ++n) {
            f32x4 v;
            if (X0 != nullptr) v = *(const f32x4*)(X0 + ro + bj * HALF + n * 16);
            else { const u32x2 q = sv[m][bj][n]; v[0] = bflo(q[0]); v[1] = bfhi(q[0]); v[2] = bflo(q[1]); v[3] = bfhi(q[1]); }
            v += acc[ai][bj][m][n];
            ss += v[0] * v[0] + v[1] * v[1] + v[2] * v[2] + v[3] * v[3];
            if (!dry) { u32x2 q; q[0] = pk2(v[0], v[1]); q[1] = pk2(v[2], v[3]); *(u32x2*)(S + ro + bj * HALF + n * 16) = q; }
          }
        ss += __shfl_xor(ss, 16); ss += __shfl_xor(ss, 32);
        if (!dry && fq == 0) ssq[(size_t)row * 16 + u.pn * 4 + wc] = ss;
      }
    }
  }
};
struct EpiSwiglu {
  static constexpr bool PERM = false, RSTD = true;
  bf16_t* Hd; const float* ssq;
  DI void operator()(const f32x4 (&acc)[2][2][4][2], const Unit& u, int wr, int wc, int fr, int fq, const PG8_LAS float* sR) const {
    const int row0 = u.pm * BM + wr * 64 + fr, j0 = (u.pn * BM + wc * 32) / 2 + 4 * fq;
#pragma unroll
    for (int ai = 0; ai < 2; ++ai)
#pragma unroll
      for (int m = 0; m < 4; ++m) {
        bf16_t* rowp = Hd + (size_t)(row0 + ai * HALF + m * 16) * 2816 + j0;
        const float rs = sR[ai * 128 + m * 16 + fr];
#pragma unroll
        for (int bj = 0; bj < 2; ++bj) {
          const f32x4 g = acc[ai][bj][m][0] * rs, up = acc[ai][bj][m][1] * rs;
          u32x2 o; o[0] = pk2(silu(g[0]) * up[0], silu(g[1]) * up[1]); o[1] = pk2(silu(g[2]) * up[2], silu(g[3]) * up[3]);
          *(u32x2*)(rowp + bj * (HALF / 2)) = o;
        }
      }
  }
};

template <class Epi>
DI void gemm_phase(PG8_LAS unsigned char* lds, const Gemm g, const StaticOrder& S, const Epi& E) {
  const int tid = otid(), wid = __builtin_amdgcn_readfirstlane(tid >> 6), lane = tid & 63, wr = wid >> 2, wc = wid & 3, fr = lane & 15, fq = lane >> 4;
  const int K = g.K, nt = K / BK;
  unsigned voffA[2], voffB[2];
#pragma unroll
  for (int i = 0; i < 2; ++i) { int R, C; stage_rc(tid * 16 + i * 8192, R, C); const int Rb = Epi::PERM ? ((R & ~31) + perm32(R & 31)) : R;
    voffA[i] = (unsigned)(R * g.lda + C) * 2u; voffB[i] = (unsigned)(Rb * K + C) * 2u; }
  const size_t kstep = (size_t)(BK * 2);
  const size_t hstepA = (size_t)HALF * g.lda * 2, hstepB = (size_t)HALF * K * 2;
  const size_t tstepA = 2 * hstepA, tstepB = 2 * hstepB;
  const unsigned ldsw = (unsigned)wid * 1024u;
  const int aoff = lds_byte(wr * 64 + fr, fq * 8), boff = lds_byte(wc * 32 + fr, fq * 8);
#define PG8_SA(b, h) (((b) * 2 + (h)) * HTB)
#define PG8_SB(b, h) ((4 + (b) * 2 + (h)) * HTB)
#define PG8_STAGE(bufoff, gbase, voff) do { _Pragma("unroll") for (int _i = 0; _i < 2; ++_i) \
    __builtin_amdgcn_global_load_lds((const unsigned*)((const char*)(gbase) + (voff)[_i]), (PG8_LAS unsigned*)(lds + (bufoff) + ldsw + _i * 8192), 16, 0, 0); } while (0)
#define PG8_LDA(dst, b, h) do { _Pragma("unroll") for (int m = 0; m < 4; ++m) _Pragma("unroll") for (int k = 0; k < 2; ++k) dst[m][k] = *(const PG8_LAS bf16x8*)(lds + PG8_SA(b, h) + aoff + m * 2048 + k * 1024); } while (0)
#define PG8_LDB(dst, b, h) do { _Pragma("unroll") for (int n = 0; n < 2; ++n) _Pragma("unroll") for (int k = 0; k < 2; ++k) dst[n][k] = *(const PG8_LAS bf16x8*)(lds + PG8_SB(b, h) + boff + n * 2048 + k * 1024); } while (0)
#define PG8_MMA(ai, bj, At, Bt) do { __builtin_amdgcn_s_setprio(1); _Pragma("unroll") for (int m = 0; m < 4; ++m) _Pragma("unroll") for (int n = 0; n < 2; ++n) _Pragma("unroll") for (int k = 0; k < 2; ++k) \
    acc[ai][bj][m][n] = __builtin_amdgcn_mfma_f32_16x16x32_bf16(Bt[n][k], At[m][k], acc[ai][bj][m][n], 0, 0, 0); __builtin_amdgcn_s_setprio(0); } while (0)
#define PG8_WAIT_V(n) asm volatile("s_waitcnt vmcnt(" #n ")" ::: "memory")
#define PG8_WAIT_L(n) asm volatile("s_waitcnt lgkmcnt(" #n ")" ::: "memory")
#define PG8_BAR __builtin_amdgcn_s_barrier()
#define PG8_SCHED __builtin_amdgcn_sched_barrier(0)
  Unit cur, nxt; int ui = 0;
  if (!S.next(0, cur)) return;
  f32x4 acc[2][2][4][2];
#pragma unroll
  for (int a = 0; a < 2; ++a)
#pragma unroll
    for (int b = 0; b < 2; ++b)
#pragma unroll
      for (int m = 0; m < 4; ++m)
#pragma unroll
        for (int n = 0; n < 2; ++n) acc[a][b][m][n] = (f32x4){0.f, 0.f, 0.f, 0.f};
  bf16x8 At[4][2], B0[2][2], B1[2][2];
  const char* cA = (const char*)g.A + (size_t)cur.pm * tstepA; const char* cB = (const char*)g.Bt + (size_t)cur.pn * tstepB;
  PG8_STAGE(PG8_SB(0, 0), cB, voffB); PG8_STAGE(PG8_SA(0, 0), cA, voffA); PG8_STAGE(PG8_SB(0, 1), cB + hstepB, voffB); PG8_STAGE(PG8_SA(0, 1), cA + hstepA, voffA);
  if (wr == 1) PG8_BAR;
  PG8_WAIT_V(4); PG8_BAR;
  PG8_STAGE(PG8_SB(1, 0), cB + kstep, voffB); PG8_STAGE(PG8_SA(1, 0), cA + kstep, voffA); PG8_STAGE(PG8_SB(1, 1), cB + hstepB + kstep, voffB);
  PG8_WAIT_V(6); PG8_BAR;
  for (;;) {
    const bool has_next = S.next(ui + 1, nxt);
    const char* nA = has_next ? (const char*)g.A + (size_t)nxt.pm * tstepA : cA; const char* nB = has_next ? (const char*)g.Bt + (size_t)nxt.pn * tstepB : cB;
    for (int t = 0; t < nt; t += 2) {
      const bool last = (t == nt - 2);
      const char* a1 = cA + (size_t)(t + 1) * kstep;
      const char* a2 = last ? nA : cA + (size_t)(t + 2) * kstep; const char* b2 = last ? nB : cB + (size_t)(t + 2) * kstep;
      const char* a3 = a2 + kstep; const char* b3 = b2 + kstep;
      PG8_LDB(B0, 0, 0); PG8_SCHED; PG8_LDA(At, 0, 0); PG8_STAGE(PG8_SA(1, 1), a1 + hstepA, voffA);
      PG8_WAIT_L(8); PG8_BAR; PG8_WAIT_L(0); PG8_MMA(0, 0, At, B0); PG8_BAR; PG8_SCHED;
      PG8_LDB(B1, 0, 1); PG8_STAGE(PG8_SB(0, 0), b2, voffB);
      PG8_BAR; PG8_WAIT_L(0); PG8_MMA(0, 1, At, B1); PG8_BAR;
      PG8_LDA(At, 0, 1); PG8_STAGE(PG8_SA(0, 0), a2, voffA);
      PG8_BAR; PG8_WAIT_L(0); PG8_MMA(1, 0, At, B0); PG8_BAR; PG8_SCHED;
      PG8_STAGE(PG8_SB(0, 1), b2 + hstepB, voffB);
      PG8_WAIT_V(6); PG8_BAR; PG8_MMA(1, 1, At, B1); PG8_BAR;
      PG8_LDB(B0, 1, 0); PG8_SCHED; PG8_LDA(At, 1, 0); PG8_STAGE(PG8_SA(0, 1), a2 + hstepA, voffA);
      PG8_WAIT_L(8); PG8_BAR; PG8_WAIT_L(0); PG8_MMA(0, 0, At, B0); PG8_BAR; PG8_SCHED;
      PG8_LDB(B1, 1, 1); PG8_STAGE(PG8_SB(1, 0), b3, voffB);
      PG8_BAR; PG8_WAIT_L(0); PG8_MMA(0, 1, At, B1); PG8_BAR;
      PG8_LDA(At, 1, 1); PG8_STAGE(PG8_SA(1, 0), a3, voffA);
      PG8_BAR; PG8_WAIT_L(0); PG8_MMA(1, 0, At, B0); PG8_BAR; PG8_SCHED;
      PG8_STAGE(PG8_SB(1, 1), b3 + hstepB, voffB);
      PG8_WAIT_V(6); PG8_BAR; PG8_MMA(1, 1, At, B1); PG8_BAR;
    }
    const PG8_LAS float* sR = (const PG8_LAS float*)(lds + 131072) + ui * 256 + wr * 64;
    E(acc, cur, wr, wc, fr, fq, sR);
    if (!has_next) break;
#pragma unroll
    for (int a = 0; a < 2; ++a)
#pragma unroll
      for (int b = 0; b < 2; ++b)
#pragma unroll
        for (int m = 0; m < 4; ++m)
#pragma unroll
          for (int n = 0; n < 2; ++n) acc[a][b][m][n] = (f32x4){0.f, 0.f, 0.f, 0.f};
    cur = nxt; cA = nA; cB = nB; ++ui;
  }
  PG8_WAIT_V(0);
  if (wr == 0) PG8_BAR;
  PG8_BAR;
#undef PG8_SA
#undef PG8_SB
#undef PG8_STAGE
#undef PG8_LDA
#undef PG8_LDB
#undef PG8_MMA
#undef PG8_WAIT_V
#undef PG8_WAIT_L
#undef PG8_BAR
#undef PG8_SCHED
}
}

template <class Epi>
DI void gemm_run(const bf16_t* A, int lda, const bf16_t* Bt, int K, int N, char* lds, const Epi& e) {
  pg8::Gemm g{A, Bt, lda, N, K};
  pg8::StaticOrder S; S.init(T, N, (int)gridDim.x, (int)blockIdx.x);
  if constexpr (Epi::RSTD) {
    __attribute__((address_space(3))) float* sRall = (__attribute__((address_space(3))) float*)(lds + 131072);
    pg8::Unit u;
    const int tq = otid();
    for (int i = tq >> 8; S.next(i, u); i += 2) sRall[i * 256 + (tq & 255)] = pg8::row_rstd(e.ssq, u.pm * 256 + (tq & 255));
  }
  __syncthreads();
  pg8::gemm_phase(( __attribute__((address_space(3))) unsigned char*)lds, g, S, e);
  __syncthreads();
}

DI void init_stream_phase(const float* Xin, bf16_t* S, float* ssq) {
  const int tid = otid(), lane = tid & 63, wave = tid >> 6;
  const int stride = gridDim.x * 8;
  for (int row0 = blockIdx.x * 8 + wave; row0 < T; row0 += stride * 2) {
    f32x4 v[2][4];
#pragma unroll
    for (int k = 0; k < 2; ++k) { const int row = (row0 + k * stride < T) ? row0 + k * stride : row0; const f32x4* xr = (const f32x4*)(Xin + (size_t)row * 1024);
#pragma unroll
      for (int j = 0; j < 4; ++j) v[k][j] = xr[lane + 64 * j]; }
#pragma unroll
    for (int k = 0; k < 2; ++k) {
      const int row = row0 + k * stride;
      if (row < T) {
        float ss = 0.f;
#pragma unroll
        for (int j = 0; j < 4; ++j) ss += v[k][j][0] * v[k][j][0] + v[k][j][1] * v[k][j][1] + v[k][j][2] * v[k][j][2] + v[k][j][3] * v[k][j][3];
        ss = wave_sum(ss);
#pragma unroll
        for (int j = 0; j < 4; ++j) { u32x2 q; q[0] = pk2(v[k][j][0], v[k][j][1]); q[1] = pk2(v[k][j][2], v[k][j][3]); *(u32x2*)(S + (size_t)row * 1024 + 4 * (lane + 64 * j)) = q; }
        if (lane < 16) ssq[(size_t)row * 16 + lane] = (lane == 0) ? ss : 0.f;
      }
    }
  }
}
DI void final_norm_phase(const bf16_t* S, const float* w, float* out) {
  const int tid = otid(), lane = tid & 63, wave = tid >> 6;
  const int stride = gridDim.x * 8;
  f32x4 wv[4];
#pragma unroll
  for (int q = 0; q < 4; ++q) wv[q] = *(const f32x4*)(w + (q >> 1) * 512 + lane * 8 + (q & 1) * 4);
  for (int row0 = blockIdx.x * 8 + wave; row0 < T; row0 += stride * 4) {
    u32x4 r[4][2];
#pragma unroll
    for (int k = 0; k < 4; ++k) { const int row = (row0 + k * stride < T) ? row0 + k * stride : row0;
      r[k][0] = *(const u32x4*)(S + (size_t)row * 1024 + lane * 8); r[k][1] = *(const u32x4*)(S + (size_t)row * 1024 + 512 + lane * 8); }
#pragma unroll
    for (int k = 0; k < 4; ++k) {
      const int row = row0 + k * stride;
      if (row < T) {
        float f[16];
        { float a[8], b2[8]; unpack8(r[k][0], a); unpack8(r[k][1], b2);
#pragma unroll
          for (int e = 0; e < 8; ++e) { f[e] = a[e]; f[8 + e] = b2[e]; } }
        float ss = 0.f;
#pragma unroll
        for (int e = 0; e < 16; ++e) ss += f[e] * f[e];
        ss = wave_sum(ss);
        const float rstd = rsqrtf(ss * (1.f / 1024.f) + 1e-5f);
#pragma unroll
        for (int hlf = 0; hlf < 2; ++hlf) {
          const int c0 = hlf * 512 + lane * 8;
          f32x4 o0, o1;
#pragma unroll
          for (int e = 0; e < 4; ++e) { o0[e] = f[hlf * 8 + e] * rstd * wv[2 * hlf][e]; o1[e] = f[hlf * 8 + 4 + e] * rstd * wv[2 * hlf + 1][e]; }
          *(f32x4*)(out + (size_t)row * 1024 + c0) = o0; *(f32x4*)(out + (size_t)row * 1024 + c0 + 4) = o1;
        }
      }
    }
  }
}

struct CvtJob { const float* src; bf16_t* dst; const float* kscale; int K, N, Npad, mode, ntiles; };
DI CvtJob cvt_job(const float* src, int K, int N, bf16_t* dst, int Npad, int mode, const float* kscale) {
  CvtJob j; j.src = src; j.dst = dst; j.kscale = kscale; j.K = K; j.N = N; j.Npad = Npad; j.mode = mode; j.ntiles = (K >> 6) * ((Npad + 255) >> 8); return j;
}
DI void convert_tile(const CvtJob& jb, int ti, char* lds) {
  float* tile = (float*)lds;
  const int tid = otid();
  const int K = jb.K, N = jb.N;
  const int nkt = K >> 6;
  const int kt = ti % nkt, nt = ti / nkt, k0 = kt * 64, n0 = nt * 256;
  const int nn = tid & 255, kr = tid >> 8;
  const int n = n0 + nn;
  float v[32];
#pragma unroll
  for (int i = 0; i < 32; ++i) v[i] = (n < N) ? jb.src[(size_t)(k0 + kr + 2 * i) * N + n] : 0.f;
#pragma unroll
  for (int i = 0; i < 32; ++i) { const int k = kr + 2 * i; tile[k * 257 + nn] = jb.kscale ? v[i] * jb.kscale[k0 + k] : v[i]; }
  __syncthreads();
#pragma unroll
  for (int j = 0; j < 4; ++j) {
    const int q = tid + 512 * j, nw = q >> 3, kc = q & 7;
    float f[8];
#pragma unroll
    for (int e = 0; e < 8; ++e) f[e] = tile[(kc * 8 + e) * 257 + nw];
    const int nr = n0 + nw;
    if (nr < jb.Npad) {
      const int drow = (jb.mode == 0) ? nr : (32 * (nr >> 4) + (nr & 15) + (jb.mode == 2 ? 16 : 0));
      *(u32x4*)(jb.dst + (size_t)drow * K + k0 + kc * 8) = pack8(f);
    }
  }
  __syncthreads();
}
template <int NJ>
DI void convert_jobs(const CvtJob (&jobs)[NJ], char* lds, int first_blk) {
  if ((int)blockIdx.x < first_blk) return;
  int total = 0;
#pragma unroll
  for (int j = 0; j < NJ; ++j) total += jobs[j].ntiles;
  for (int ti = (int)blockIdx.x - first_blk; ti < total; ti += (int)gridDim.x - first_blk) {
    int rem = ti; bool done = false;
#pragma unroll
    for (int j = 0; j < NJ; ++j) {
      if (!done) { if (rem < jobs[j].ntiles) { convert_tile(jobs[j], rem, lds); done = true; } else rem -= jobs[j].ntiles; }
    }
  }
}
DI void convert_ffn(const Params& p, int L, char* lds, int first_blk) {
  const float* nw2 = p.ffn_norm_w + L * 1024;
  const CvtJob jobs[3] = {
    cvt_job(p.w_gate + (size_t)L * 1024 * 2816, 1024, 2816, p.Wb + W_GU, 2816, 1, nw2), cvt_job(p.w_up + (size_t)L * 1024 * 2816, 1024, 2816, p.Wb + W_GU, 2816, 2, nw2),
    cvt_job(p.w_down + (size_t)L * 2816 * 1024, 2816, 1024, p.Wb + W_DN, 1024, 0, nullptr)};
  convert_jobs(jobs, lds, first_blk);
}
DI void convert_mixer(const Params& p, int L, char* lds, int first_blk) {
  const int i = L >> 1; bf16_t* Wb = p.Wb;
  const float* nw1 = p.mix_norm_w + L * 1024;
  if (!(L & 1)) {
    const CvtJob jobs[6] = {
      cvt_job(p.ap_w_in + (size_t)i * 1024 * 1280, 1024, 1280, Wb + W_IN, 1280, 0, nw1), cvt_job(p.ap_w_out + (size_t)i * 1024 * 1024, 1024, 1024, Wb + W_OUT, 1024, 0, nullptr),
      cvt_job(p.pool_w + (size_t)(i * 4 + 0) * 16384, 128, 128, Wb + W_POOL, 128, 0, nullptr), cvt_job(p.pool_w + (size_t)(i * 4 + 1) * 16384, 128, 128, Wb + W_POOL + 16384, 128, 0, nullptr),
      cvt_job(p.pool_w + (size_t)(i * 4 + 2) * 16384, 128, 128, Wb + W_POOL + 32768, 128, 0, nullptr), cvt_job(p.pool_w + (size_t)(i * 4 + 3) * 16384, 128, 128, Wb + W_POOL + 49152, 128, 0, nullptr)};
    convert_jobs(jobs, lds, first_blk);
  } else {
    const CvtJob jobs[2] = {
      cvt_job(p.ssd_w_in + (size_t)i * 1024 * 5152, 1024, 5152, Wb + W_IN, 5376, 0, nw1), cvt_job(p.ssd_w_out + (size_t)i * 2048 * 1024, 2048, 1024, Wb + W_OUT, 1024, 0, nullptr)};
    convert_jobs(jobs, lds, first_blk);
  }
}
DI int idle_from(int nunits) { const int r = nunits % (int)gridDim.x; return r; }

#define LDS_BARRIER() do { asm volatile("s_waitcnt lgkmcnt(0)" ::: "memory"); __builtin_amdgcn_s_barrier(); asm volatile("" ::: "memory"); } while (0)
DI void attn_phase(const bf16_t* proj, bf16_t* cat, const float* sinks, char* lds) {
  char* sK = lds; char* sVt = lds + 32768;
  const int tid = otid(), lane = tid & 63, wave = tid >> 6, h = lane >> 5, l31 = lane & 31;
  const int swz = (lane >> 1) & 7;
  for (int item = blockIdx.x; item < 256; item += gridDim.x) {
    const int kvh = item & 1, nb = (item >> 1) & 63, b = item >> 7;
    const int tok0 = b * SEQ + nb * 128;
    u32x4 kv[8];
#pragma unroll
    for (int j = 0; j < 4; ++j) {
      const int q = tid + 512 * j;
      { const int key = q >> 3, c = q & 7; const bool ok = (nb > 0 || key >= 128);
        kv[j] = *(const u32x4*)(proj + (size_t)(ok ? (tok0 - 128 + key) : tok0) * 1280 + 512 + kvh * 64 + c * 8); }
      { const int key = q & 255, c = q >> 8; const bool ok = (nb > 0 || key >= 128);
        kv[4 + j] = *(const u32x4*)(proj + (size_t)(ok ? (tok0 - 128 + key) : tok0) * 1280 + 640 + kvh * 64 + c * 8); }
    }
#pragma unroll
    for (int j = 0; j < 4; ++j) {
      const int q = tid + 512 * j, key = q >> 3, c = q & 7;
      u32x4 v = kv[j];
      if (!(nb > 0 || key >= 128)) v = (u32x4){0u, 0u, 0u, 0u};
      *(u32x4*)(sK + swz64(key, c)) = v;
    }
#pragma unroll
    for (int j = 0; j < 4; ++j) {
      const int q = tid + 512 * j, key = q & 255, c = q >> 8;
      u32x4 v = kv[4 + j];
      if (!(nb > 0 || key >= 128)) v = (u32x4){0u, 0u, 0u, 0u};
#pragma unroll
      for (int e = 0; e < 8; ++e) *(bf16_t*)(sVt + (c * 8 + e) * 520 + key * 2) = (bf16_t)(v[e >> 1] >> (16 * (e & 1)));
    }
    __syncthreads();
#pragma unroll 1
    for (int task = 0; task < 2; ++task) {
      const int g = wave >> 1, sb = (wave & 1) * 2 + task, head = kvh * 4 + g, q0 = sb * 32;
      const int qi = q0 + l31;
      const size_t qtok = (size_t)tok0 + qi;
      bf16x8 qf[4];
#pragma unroll
      for (int kk = 0; kk < 4; ++kk) qf[kk] = *(const bf16x8*)(proj + qtok * 1280 + head * 64 + kk * 16 + 8 * h);
      f32x16 s[5];
#pragma unroll
      for (int t = 0; t < 5; ++t) {
#pragma unroll
        for (int i = 0; i < 16; ++i) s[t][i] = 0.f;
        const char* kp = sK + (32 * (sb + t) + l31) * 128;
#pragma unroll
        for (int kk = 0; kk < 4; ++kk) { const bf16x8 kf = *(const bf16x8*)(kp + (((kk * 2 + h) ^ swz) << 4)); s[t] = MFMA(kf, qf[kk], s[t]); }
      }
      const float sink = sinks[head];
      float mx = sink;
#pragma unroll
      for (int t = 0; t < 5; ++t)
#pragma unroll
        for (int i = 0; i < 16; ++i) {
          const float pen = (nb > 0 || sb + t >= 4) ? 0.f : -1e30f;
          float sv = s[t][i] * 0.125f + pen;
          if (t == 0) sv = (crow(i, h) > l31) ? sv : -1e30f;
          if (t == 4) sv = (crow(i, h) <= l31) ? sv : -1e30f;
          s[t][i] = sv; mx = fmaxf(mx, sv);
        }
      mx = fmaxf(mx, __shfl_xor(mx, 32));
      float sum = 0.f;
#pragma unroll
      for (int t = 0; t < 5; ++t)
#pragma unroll
        for (int i = 0; i < 16; ++i) { const float pv = __expf(s[t][i] - mx); s[t][i] = pv; sum += pv; }
      sum += __shfl_xor(sum, 32);
      sum += __expf(sink - mx);
      f32x16 o[2];
#pragma unroll
      for (int mi = 0; mi < 2; ++mi)
#pragma unroll
        for (int i = 0; i < 16; ++i) o[mi][i] = 0.f;
#pragma unroll
      for (int t = 0; t < 5; ++t)
#pragma unroll
        for (int s2 = 0; s2 < 2; ++s2) {
          u32x4 pp;
#pragma unroll
          for (int e = 0; e < 4; ++e) pp[e] = pk2(s[t][8 * s2 + 2 * e], s[t][8 * s2 + 2 * e + 1]);
          const bf16x8 pf = __builtin_bit_cast(bf16x8, pp);
#pragma unroll
          for (int mi = 0; mi < 2; ++mi) {
            const char* vp = sVt + (mi * 32 + l31) * 520 + (32 * (sb + t) + 16 * s2 + 4 * h) * 2;
            const s16x4 lo = *(const s16x4*)vp; const s16x4 hi = *(const s16x4*)(vp + 16);
            const bf16x8 vf = __builtin_shufflevector(lo, hi, 0, 1, 2, 3, 4, 5, 6, 7);
            o[mi] = MFMA(vf, pf, o[mi]);
          }
        }
      const float inv = 1.f / sum;
#pragma unroll
      for (int mi = 0; mi < 2; ++mi)
#pragma unroll
        for (int gi = 0; gi < 4; ++gi) {
          u32x2 ov; ov[0] = pk2(o[mi][4 * gi] * inv, o[mi][4 * gi + 1] * inv); ov[1] = pk2(o[mi][4 * gi + 2] * inv, o[mi][4 * gi + 3] * inv);
          *(u32x2*)(cat + qtok * 1024 + head * 64 + mi * 32 + 8 * gi + 4 * h) = ov;
        }
    }
    __syncthreads();
  }
}

template <int W, int UB>
DI void pool_fill(const bf16_t* proj, const bf16_t* Wp, char* sD, char* sW, int tid, int t0, int tin0, int g) {
#pragma unroll 1
  for (int jb = 0; jb < 4; jb += UB) {
    u32x4 cu[UB], rr[UB][W - 1], wv[UB];
#pragma unroll
    for (int u = 0; u < UB; ++u) {
      const int q = tid + 512 * (jb + u), tok = q >> 4, c = q & 15, tin = tin0 + tok;
      const bf16_t* pp = proj + (size_t)(t0 + tok) * 1280 + 768 + g * 128 + c * 8;
      cu[u] = *(const u32x4*)pp;
#pragma unroll
      for (int i = 1; i < W; ++i) rr[u][i - 1] = *(const u32x4*)(pp - (size_t)((i <= tin) ? i : 0) * 1280);
      wv[u] = *(const u32x4*)(Wp + (size_t)g * 16384 + tok * 128 + c * 8);
    }
#pragma unroll
    for (int u = 0; u < UB; ++u) {
      const int q = tid + 512 * (jb + u), tok = q >> 4, c = q & 15, tin = tin0 + tok;
      float cur[8], sum[8], d[8];
      unpack8(cu[u], cur);
#pragma unroll
      for (int e = 0; e < 8; ++e) sum[e] = cur[e];
#pragma unroll
      for (int i = 1; i < W; ++i) {
        float f[8]; unpack8(rr[u][i - 1], f);
        const float m = (i <= tin) ? 1.f : 0.f;
#pragma unroll
        for (int e = 0; e < 8; ++e) sum[e] += m * f[e];
      }
      const int cnt = (tin + 1 < W) ? (tin + 1) : W;
      const float ic = 1.f / (float)cnt;
#pragma unroll
      for (int e = 0; e < 8; ++e) d[e] = sum[e] * ic - cur[e];
      *(u32x4*)(sD + swz128(tok, c)) = pack8(d);
      *(u32x4*)(sW + swz128(tok, c)) = wv[u];
    }
  }
}
DI void pool_phase(const bf16_t* proj, bf16_t* cat, const bf16_t* Wp, const float* scale, char* lds) {
  char* sD = lds; char* sW = lds + 32768;
  const int tid = otid(), lane = tid & 63, wave = tid >> 6, h = lane >> 5, l31 = lane & 31;
  for (int item = blockIdx.x; item < 512; item += gridDim.x) {
    const int g = item & 3, tt = item >> 2, t0 = tt * 128, tin0 = t0 & (SEQ - 1);
    if (g == 0) pool_fill<2, 4>(proj, Wp, sD, sW, tid, t0, tin0, g); else if (g == 1) pool_fill<4, 4>(proj, Wp, sD, sW, tid, t0, tin0, g);
    else if (g == 2) pool_fill<8, 2>(proj, Wp, sD, sW, tid, t0, tin0, g); else pool_fill<16, 1>(proj, Wp, sD, sW, tid, t0, tin0, g);
    __syncthreads();
    const int tk = wave & 3, dt0 = (wave >> 2) * 2;
    f32x16 acc[2];
#pragma unroll
    for (int e = 0; e < 2; ++e)
#pragma unroll
      for (int i = 0; i < 16; ++i) acc[e][i] = 0.f;
#pragma unroll
    for (int kk = 0; kk < 8; ++kk) {
      const bf16x8 yf = *(const bf16x8*)(sD + swz128(32 * tk + l31, 2 * kk + h));
#pragma unroll
      for (int e = 0; e < 2; ++e) {
        const bf16x8 xf = *(const bf16x8*)(sW + swz128(32 * (dt0 + e) + l31, 2 * kk + h));
        acc[e] = MFMA(xf, yf, acc[e]);
      }
    }
    const size_t tok = (size_t)t0 + 32 * tk + l31;
    f32x4 scv[2][4];
#pragma unroll
    for (int e = 0; e < 2; ++e)
#pragma unroll
      for (int gi = 0; gi < 4; ++gi) scv[e][gi] = *(const f32x4*)(scale + g * 128 + 32 * (dt0 + e) + 8 * gi + 4 * h);
#pragma unroll
    for (int e = 0; e < 2; ++e)
#pragma unroll
      for (int gi = 0; gi < 4; ++gi) {
        const int dout = 32 * (dt0 + e) + 8 * gi + 4 * h;
        const f32x4 sc = scv[e][gi];
        u32x2 ov; ov[0] = pk2(acc[e][4 * gi] * sc[0], acc[e][4 * gi + 1] * sc[1]); ov[1] = pk2(acc[e][4 * gi + 2] * sc[2], acc[e][4 * gi + 3] * sc[3]);
        *(u32x2*)(cat + tok * 1024 + 512 + g * 128 + dout) = ov;
      }
    LDS_BARRIER();
  }
}

DI void conv8(const bf16_t* P, size_t tok, int tin, int col, const float* cw, const float* cb, float (&out)[8]) {
  float a[8];
  { const f32x4 b0 = *(const f32x4*)(cb + col), b1 = *(const f32x4*)(cb + col + 4);
    a[0] = b0[0]; a[1] = b0[1]; a[2] = b0[2]; a[3] = b0[3]; a[4] = b1[0]; a[5] = b1[1]; a[6] = b1[2]; a[7] = b1[3]; }
  u32x4 raw[4];
#pragma unroll
  for (int kk = 0; kk < 4; ++kk) raw[kk] = *(const u32x4*)(P + (tok - ((tin - 3 + kk >= 0) ? (3 - kk) : 0)) * 5120 + 2048 + col);
#pragma unroll
  for (int kk = 0; kk < 4; ++kk) {
    float f[8]; unpack8(raw[kk], f);
    const float ok = (tin - 3 + kk >= 0) ? 1.f : 0.f;
    const f32x4 w0 = *(const f32x4*)(cw + kk * 3072 + col) * ok, w1 = *(const f32x4*)(cw + kk * 3072 + col + 4) * ok;
    a[0] += w0[0] * f[0]; a[1] += w0[1] * f[1]; a[2] += w0[2] * f[2]; a[3] += w0[3] * f[3];
    a[4] += w1[0] * f[4]; a[5] += w1[1] * f[5]; a[6] += w1[2] * f[6]; a[7] += w1[3] * f[7];
  }
#pragma unroll
  for (int e = 0; e < 8; ++e) out[e] = silu(a[e]);
}

DI void ssd_cb_phase(const bf16_t* P, bf16_t* BT, bf16_t* Cc, bf16_t* CB, const float* dt, float* acs,
                     const float* cw, const float* cb, const float* A_log, char* lds) {
  char* sB = lds; char* sC = lds + 32768;
  const int tid = otid(), lane = tid & 63, wave = tid >> 6, h = lane >> 5, l31 = lane & 31;
  for (int item = blockIdx.x; item < 512; item += gridDim.x) {
    const int g = item & 3, c = (item >> 2) & 63, b = item >> 8;
    const size_t t0 = (size_t)b * SEQ + c * 128;
    const int tin0 = c * 128;
    bf16_t* BTi = BT + (size_t)item * 16384; bf16_t* Cci = Cc + (size_t)item * 16384; bf16_t* CBi = CB + (size_t)item * 16384;
    float* sW = (float*)(lds + 65536);
    u32x4 raw[4][4];
#pragma unroll
    for (int j = 0; j < 4; ++j) {
      const int q = tid + 512 * j;
      const int lb = q & 127, cb8 = q >> 7;
#pragma unroll
      for (int kk = 0; kk < 4; ++kk) raw[j][kk] = *(const u32x4*)(P + (t0 + lb - ((tin0 + lb - 3 + kk >= 0) ? (3 - kk) : 0)) * 5120 + 2048 + 2048 + g * 128 + cb8 * 8);
    }
    for (int q = tid; q < 1280; q += 512) { const int which = q / 640, r = q % 640, kk = r >> 7, col = 2048 + which * 512 + g * 128 + (r & 127); sW[q] = (kk < 4) ? cw[kk * 3072 + col] : cb[col]; }
    LDS_BARRIER();
#pragma unroll
    for (int j = 0; j < 4; ++j) {
      const int q = tid + 512 * j, l = q & 127, cch = q >> 7;
      float v[8];
      { const f32x4 b0 = *(const f32x4*)(sW + 512 + cch * 8), b1 = *(const f32x4*)(sW + 512 + cch * 8 + 4);
        v[0] = b0[0]; v[1] = b0[1]; v[2] = b0[2]; v[3] = b0[3]; v[4] = b1[0]; v[5] = b1[1]; v[6] = b1[2]; v[7] = b1[3]; }
#pragma unroll
      for (int kk = 0; kk < 4; ++kk) {
        float f[8]; unpack8(raw[j][kk], f);
        const float ok = (tin0 + l - 3 + kk >= 0) ? 1.f : 0.f;
        const f32x4 w0 = *(const f32x4*)(sW + kk * 128 + cch * 8) * ok, w1 = *(const f32x4*)(sW + kk * 128 + cch * 8 + 4) * ok;
        v[0] += w0[0] * f[0]; v[1] += w0[1] * f[1]; v[2] += w0[2] * f[2]; v[3] += w0[3] * f[3];
        v[4] += w1[0] * f[4]; v[5] += w1[1] * f[5]; v[6] += w1[2] * f[6]; v[7] += w1[3] * f[7];
      }
#pragma unroll
      for (int e = 0; e < 8; ++e) v[e] = silu(v[e]);
      const u32x4 pk = pack8(v);
      *(u32x4*)(sB + swz128(l, cch)) = pk;
#pragma unroll
      for (int e = 0; e < 8; ++e) BTi[(cch * 8 + e) * 128 + l] = (bf16_t)(pk[e >> 1] >> (16 * (e & 1)));
      { const int lc = q >> 4, cc8 = q & 15;
#pragma unroll
        for (int kk = 0; kk < 4; ++kk) raw[j][kk] = *(const u32x4*)(P + (t0 + lc - ((tin0 + lc - 3 + kk >= 0) ? (3 - kk) : 0)) * 5120 + 2048 + 2560 + g * 128 + cc8 * 8); }
    }
#pragma unroll
    for (int j = 0; j < 4; ++j) {
      const int q = tid + 512 * j, l = q >> 4, cch = q & 15;
      float v[8];
      { const f32x4 b0 = *(const f32x4*)(sW + 640 + 512 + cch * 8), b1 = *(const f32x4*)(sW + 640 + 512 + cch * 8 + 4);
        v[0] = b0[0]; v[1] = b0[1]; v[2] = b0[2]; v[3] = b0[3]; v[4] = b1[0]; v[5] = b1[1]; v[6] = b1[2]; v[7] = b1[3]; }
#pragma unroll
      for (int kk = 0; kk < 4; ++kk) {
        float f[8]; unpack8(raw[j][kk], f);
        const float ok = (tin0 + l - 3 + kk >= 0) ? 1.f : 0.f;
        const f32x4 w0 = *(const f32x4*)(sW + 640 + kk * 128 + cch * 8) * ok, w1 = *(const f32x4*)(sW + 640 + kk * 128 + cch * 8 + 4) * ok;
        v[0] += w0[0] * f[0]; v[1] += w0[1] * f[1]; v[2] += w0[2] * f[2]; v[3] += w0[3] * f[3];
        v[4] += w1[0] * f[4]; v[5] += w1[1] * f[5]; v[6] += w1[2] * f[6]; v[7] += w1[3] * f[7];
      }
#pragma unroll
      for (int e = 0; e < 8; ++e) v[e] = silu(v[e]);
      const u32x4 pk = pack8(v);
      *(u32x4*)(sC + swz128(l, cch)) = pk;
      *(u32x4*)(Cci + l * 128 + cch * 8) = pk;
    }
    {
      const int hh = 8 * g + wave;
      const float Ah = -__expf(A_log[hh]);
      const int l0 = 2 * lane;
      const float d0 = dt[(t0 + l0) * 32 + hh] * Ah, d1 = dt[(t0 + l0 + 1) * 32 + hh] * Ah;
      float sc = d0 + d1;
#pragma unroll
      for (int o = 1; o < 64; o <<= 1) { const float v = __shfl_up(sc, o); if (lane >= o) sc += v; }
      acs[(t0 + l0) * 32 + hh] = sc - d1;
      acs[(t0 + l0 + 1) * 32 + hh] = sc;
    }
    LDS_BARRIER();
    const int lt = wave & 3, st0 = (wave >> 2) * 2;
    f32x16 acc[2];
#pragma unroll
    for (int e = 0; e < 2; ++e)
#pragma unroll
      for (int i = 0; i < 16; ++i) acc[e][i] = 0.f;
#pragma unroll
    for (int kk = 0; kk < 8; ++kk) {
      const bf16x8 yf = *(const bf16x8*)(sC + swz128(32 * lt + l31, 2 * kk + h));
#pragma unroll
      for (int e = 0; e < 2; ++e) {
        const bf16x8 xf = *(const bf16x8*)(sB + swz128(32 * (st0 + e) + l31, 2 * kk + h));
        acc[e] = MFMA(xf, yf, acc[e]);
      }
    }
    const int l = 32 * lt + l31;
#pragma unroll
    for (int e = 0; e < 2; ++e)
#pragma unroll
      for (int gi = 0; gi < 4; ++gi) {
        const int s = 32 * (st0 + e) + 8 * gi + 4 * h;
        u32x2 ov; ov[0] = pk2(acc[e][4 * gi], acc[e][4 * gi + 1]); ov[1] = pk2(acc[e][4 * gi + 2], acc[e][4 * gi + 3]);
        *(u32x2*)(CBi + l * 128 + s) = ov;
      }
    LDS_BARRIER();
  }
}

DI void ssd_scan_phase(bf16_t* P, const bf16_t* BT, const bf16_t* Cc, const bf16_t* CB, const float* dt, const float* acs,
                       const float* cw, const float* cb, const float* Dp, char* lds, bool dry, int mode, float* Sbuf) {
  char* sCBL = lds; char* sC = lds + 32768; char* sBT = lds + 65536; char* sXdt = lds + 98304; char* sXds = lds + 106496;
  char* sSt = lds + 114688;
  char* sXs = lds + 131072;
  float* sAcs = (float*)(lds + 141312);
  float* sDt = (float*)(lds + 142336);
  float* sCw = (float*)(lds + 143360);
  const int tid = otid(), lane = tid & 63, wave = tid >> 6, h = lane >> 5, l31 = lane & 31;
  const int r0_ = tid >> 4, cch_ = tid & 15, r0 = r0_, cch = cch_;
  const int xl_ = 2 * ((tid - 256) & 63), xc_ = (tid - 256) >> 6, xl = xl_, xc = xc_;
  for (int item0 = blockIdx.x; item0 < 256; item0 += gridDim.x) {
    const int item = item0 & 127, seg = item0 >> 7, c0 = mode ? seg * 16 : seg * 32, c1 = c0 + (mode ? 16 : 32);
    const bool zero_init = (mode == 1) || (seg == 0);
    const int grp = item & 7, mem = (item >> 3) & 15, b = grp >> 2, g = grp & 3, hh = 8 * g + (mem >> 1), ph = mem & 1;
    const int pcol = hh * 64 + ph * 32;
    const float Dh = Dp[hh];
    f32x16 st;
#pragma unroll
    for (int i = 0; i < 16; ++i) st[i] = 0.f;
    if (zero_init) { for (int q = tid; q < 2048; q += 512) ((unsigned*)sSt)[q] = 0u; }
    else if (wave >= 4) {
      float dsum = 0.f;
      for (int cc = 16; cc < 32; ++cc) dsum += acs[((size_t)b * SEQ + cc * 128 + 127) * 32 + hh];
      const float Db = __expf(dsum);
      const float* spa = Sbuf + ((size_t)item * 4 + (wave - 4)) * 1024 + lane * 16;
      const float* spb = spa + (size_t)128 * 4 * 1024;
#pragma unroll
      for (int gi = 0; gi < 4; ++gi) { const f32x4 va = *(const f32x4*)(spa + 4 * gi), vb = *(const f32x4*)(spb + 4 * gi); const f32x4 v = va * Db + vb;
        st[4 * gi] = v[0]; st[4 * gi + 1] = v[1]; st[4 * gi + 2] = v[2]; st[4 * gi + 3] = v[3];
        u32x2 ov; ov[0] = pk2(v[0], v[1]); ov[1] = pk2(v[2], v[3]);
        *(u32x2*)(sSt + l31 * 256 + (((4 * (wave - 4) + gi) ^ (l31 & 15)) << 4) + 8 * h) = ov; }
    }
    if (tid < 160) sCw[tid] = (tid < 128) ? cw[(tid >> 5) * 3072 + pcol + (tid & 31)] : cb[pcol + tid - 128];
    const size_t tb = (size_t)b * SEQ, tbs = tb + (size_t)c0 * 128;
    const size_t cbi0 = ((size_t)(b * 64) * 4 + g) * 16384;
    const unsigned toff = r0 * 128 + cch * 8;
    const unsigned xoff = xl * 5120 + xc * 8;
    const unsigned zoff = (32 * (wave & 3) + l31) * 5120 + 4 * h;
    u32x4 rC[4], rB[4], rCB[4], rX[5];
    u32x2 cz[4];
    float racs = 0.f, rdt = 0.f;
    unsigned tchA = 0u, tchB = 0u, tsum = 0u;
    {
      const size_t cbis = cbi0 + (size_t)c0 * 65536;
      const bf16_t* Cq = Cc + cbis; const bf16_t* Bq = BT + cbis; const bf16_t* CBq = CB + cbis;
#pragma unroll
      for (int j = 0; j < 4; ++j) { rB[j] = *(const u32x4*)(Bq + toff + j * 4096); rC[j] = (u32x4){0u, 0u, 0u, 0u}; rCB[j] = (u32x4){0u, 0u, 0u, 0u};
        if (mode == 0) { rC[j] = *(const u32x4*)(Cq + toff + j * 4096); rCB[j] = *(const u32x4*)(CBq + toff + j * 4096); } }
      const bf16_t* Xq = P + tbs * 5120 + 2048 + pcol;
#pragma unroll
      for (int kk = 0; kk < 5; ++kk) {
        rX[kk] = (u32x4){0u, 0u, 0u, 0u};
        if (wave >= 4 && (c0 > 0 || xl - 3 + kk >= 0)) rX[kk] = *(const u32x4*)(Xq + (xl - 3 + kk) * 5120 + xc * 8);
      }
      const bf16_t* Zq = P + tbs * 5120 + pcol;
#pragma unroll
      for (int gi = 0; gi < 4; ++gi) cz[gi] = (u32x2){0u, 0u};
      if (wave < 4 && mode == 0) {
#pragma unroll
        for (int gi = 0; gi < 4; ++gi) cz[gi] = *(const u32x2*)(Zq + zoff + 8 * gi);
      }
      const float* aq = acs + tbs * 32 + hh; const float* dq = dt + tbs * 32 + hh;
      if (tid < 128) { sAcs[tid] = aq[tid * 32]; sDt[tid] = dq[tid * 32]; racs = aq[4096 + tid * 32]; rdt = dq[4096 + tid * 32]; }
    }
    __syncthreads();
#pragma unroll 1
    for (int c = c0; c < c1; ++c) {
      const size_t t0 = tb + c * 128;
      const float* cAcs = sAcs + (c & 1) * 128; const float* cDt = sDt + (c & 1) * 128;
      {
        int xl = xl_, xc = xc_, r0 = r0_, cch = cch_;
        asm volatile("" : "+v"(xl), "+v"(xc), "+v"(r0), "+v"(cch));
        const f32x4 a0 = *(const f32x4*)(cAcs + cch * 8), a1 = *(const f32x4*)(cAcs + cch * 8 + 4);
        const float L2E = 1.44269504f;
        const float as[8] = {a0[0] * L2E, a0[1] * L2E, a0[2] * L2E, a0[3] * L2E, a1[0] * L2E, a1[1] * L2E, a1[2] * L2E, a1[3] * L2E};
#pragma unroll
        for (int j = 0; j < 4; ++j) {
          const int r = r0 + 32 * j;
          *(u32x4*)(sBT + swz128(r, cch)) = rB[j];
          if (mode == 0) {
            *(u32x4*)(sC + swz128(r, cch)) = rC[j];
            float f[8]; unpack8(rCB[j], f);
            const float el = cAcs[r] * L2E;
            const int lim = r - cch * 8;
#pragma unroll
            for (int e = 0; e < 8; ++e) f[e] = (e <= lim) ? f[e] * __builtin_amdgcn_exp2f(el - as[e]) : 0.f;
            *(u32x4*)(sCBL + swz128(r, cch)) = pack8(f);
          }
        }
        if (wave >= 4) {
          float a[8], bq[8];
          { const f32x4 b0 = *(const f32x4*)(sCw + 128 + xc * 8), b1 = *(const f32x4*)(sCw + 128 + xc * 8 + 4);
            a[0] = b0[0]; a[1] = b0[1]; a[2] = b0[2]; a[3] = b0[3]; a[4] = b1[0]; a[5] = b1[1]; a[6] = b1[2]; a[7] = b1[3]; }
#pragma unroll
          for (int e = 0; e < 8; ++e) bq[e] = a[e];
#pragma unroll
          for (int kk = 0; kk < 4; ++kk) {
            float f[8], f2[8]; unpack8(rX[kk], f); unpack8(rX[kk + 1], f2);
            const f32x4 w0 = *(const f32x4*)(sCw + kk * 32 + xc * 8), w1 = *(const f32x4*)(sCw + kk * 32 + xc * 8 + 4);
            a[0] += w0[0] * f[0]; a[1] += w0[1] * f[1]; a[2] += w0[2] * f[2]; a[3] += w0[3] * f[3];
            a[4] += w1[0] * f[4]; a[5] += w1[1] * f[5]; a[6] += w1[2] * f[6]; a[7] += w1[3] * f[7];
            bq[0] += w0[0] * f2[0]; bq[1] += w0[1] * f2[1]; bq[2] += w0[2] * f2[2]; bq[3] += w0[3] * f2[3];
            bq[4] += w1[0] * f2[4]; bq[5] += w1[1] * f2[5]; bq[6] += w1[2] * f2[6]; bq[7] += w1[3] * f2[7];
          }
#pragma unroll
          for (int e = 0; e < 8; ++e) { a[e] = silu(a[e]); bq[e] = silu(bq[e]); }
          if (mode == 0) { *(u32x4*)(sXs + xl * 80 + xc * 16) = pack8(a); *(u32x4*)(sXs + (xl + 1) * 80 + xc * 16) = pack8(bq); }
          const float e127 = cAcs[127];
          const float dlA = cDt[xl], dlB = cDt[xl + 1];
          const float dsA = dlA * __expf(e127 - cAcs[xl]), dsB = dlB * __expf(e127 - cAcs[xl + 1]);
#pragma unroll
          for (int e = 0; e < 8; ++e) {
            const int pr = xc * 8 + e;
            const int off = pr * 256 + (((xl >> 3) ^ (pr & 15)) << 4) + (xl & 7) * 2;
            if (mode == 0) *(unsigned*)(sXdt + off) = pk2(a[e] * dlA, bq[e] * dlB);
            *(unsigned*)(sXds + off) = pk2(a[e] * dsA, bq[e] * dsB);
          }
        }
      }
      float nacs = 0.f, ndt = 0.f;
      tsum += tchA + tchB;
      if (c + 2 < c1) {
        const size_t cb2 = cbi0 + (size_t)(c + 2) * 65536;
        const int tl = tid & 255;
        tchA = *(const unsigned*)((tid < 256 ? Cc : BT) + cb2 + tl * 64);
        const bf16_t* rowp = P + (t0 + 256 + (tid & 127)) * 5120 + pcol + ((tid < 384) ? 2048 : 0);
        tchB = *(const unsigned*)((tid < 256) ? (CB + cb2 + tl * 64) : rowp);
      }
      if (c + 1 < c1) {
        if (c + 2 < c1 && tid < 128) { nacs = (acs + (t0 + 256) * 32 + hh)[tid * 32]; ndt = (dt + (t0 + 256) * 32 + hh)[tid * 32]; }
        const size_t cbi = cbi0 + (size_t)(c + 1) * 65536;
        const bf16_t* Cq = Cc + cbi; const bf16_t* Bq = BT + cbi; const bf16_t* CBq = CB + cbi;
#pragma unroll
        for (int j = 0; j < 4; ++j) { rB[j] = *(const u32x4*)(Bq + toff + j * 4096); if (mode == 0) { rC[j] = *(const u32x4*)(Cq + toff + j * 4096); rCB[j] = *(const u32x4*)(CBq + toff + j * 4096); } }
        const bf16_t* Xq = P + (t0 + 125) * 5120 + 2048 + pcol;
#pragma unroll
        for (int kk = 0; kk < 5; ++kk) { if (wave >= 4) rX[kk] = *(const u32x4*)(Xq + xoff + kk * 5120); }
      }
      __builtin_amdgcn_sched_barrier(0);
      LDS_BARRIER();
      int lq = l31, hq = h;
      asm volatile("" : "+v"(lq), "+v"(hq));
      if (wave < 4) {
       if (mode == 0) {
        const int lt = wave;
        f32x16 ad, ao;
#pragma unroll
        for (int i = 0; i < 16; ++i) { ad[i] = 0.f; ao[i] = 0.f; }
        const char* stb = sSt + (c & 1) * 8192;
#pragma unroll
        for (int kk = 0; kk < 8; ++kk) {
          const bf16x8 yf = *(const bf16x8*)(sCBL + swz128(32 * lt + lq, 2 * kk + hq));
          const bf16x8 xf = *(const bf16x8*)(sXdt + swz128(lq, 2 * kk + hq));
          ad = MFMA(xf, yf, ad);
          const bf16x8 yf2 = *(const bf16x8*)(sC + swz128(32 * lt + lq, 2 * kk + hq));
          const bf16x8 xf2 = *(const bf16x8*)(stb + swz128(lq, 2 * kk + hq));
          ao = MFMA(xf2, yf2, ao);
        }
        const int l = 32 * lt + l31;
        const float eo = __expf(cAcs[l]);
        bf16_t* Zq = P + t0 * 5120 + pcol;
#pragma unroll
        for (int gi = 0; gi < 4; ++gi) {
          const int p0 = 8 * gi + 4 * h;
          const u32x2 xsv = *(const u32x2*)(sXs + l * 80 + p0 * 2);
          const u32x2 zv = cz[gi];
          const float xs0 = bflo(xsv[0]), xs1 = bfhi(xsv[0]), xs2 = bflo(xsv[1]), xs3 = bfhi(xsv[1]);
          const float z0 = bflo(zv[0]), z1 = bfhi(zv[0]), z2 = bflo(zv[1]), z3 = bfhi(zv[1]);
          const float y0 = (ad[4 * gi] + eo * ao[4 * gi] + Dh * xs0) * silu(z0);
          const float y1 = (ad[4 * gi + 1] + eo * ao[4 * gi + 1] + Dh * xs1) * silu(z1);
          const float y2 = (ad[4 * gi + 2] + eo * ao[4 * gi + 2] + Dh * xs2) * silu(z2);
          const float y3 = (ad[4 * gi + 3] + eo * ao[4 * gi + 3] + Dh * xs3) * silu(z3);
          u32x2 ov; ov[0] = pk2(y0, y1); ov[1] = pk2(y2, y3);
          if (!dry) *(u32x2*)(Zq + zoff + 8 * gi) = ov;
        }
        if (c + 1 < c1) {
#pragma unroll
          for (int gi = 0; gi < 4; ++gi) cz[gi] = *(const u32x2*)(Zq + 128 * 5120 + zoff + 8 * gi);
        }
       }
      } else {
        const int nt = wave - 4;
        const float dec = __expf(cAcs[127]);
#pragma unroll
        for (int i = 0; i < 16; ++i) st[i] *= dec;
#pragma unroll
        for (int kk = 0; kk < 8; ++kk) {
          const bf16x8 xf = *(const bf16x8*)(sBT + swz128(32 * nt + lq, 2 * kk + hq));
          const bf16x8 yf = *(const bf16x8*)(sXds + swz128(lq, 2 * kk + hq));
          st = MFMA(xf, yf, st);
        }
        char* stn = sSt + ((c + 1) & 1) * 8192;
#pragma unroll
        for (int gi = 0; gi < 4; ++gi) {
          u32x2 ov; ov[0] = pk2(st[4 * gi], st[4 * gi + 1]); ov[1] = pk2(st[4 * gi + 2], st[4 * gi + 3]);
          *(u32x2*)(stn + l31 * 256 + (((4 * nt + gi) ^ (l31 & 15)) << 4) + 8 * h) = ov;
        }
      }
      if (tid < 128) { sAcs[((c + 1) & 1) * 128 + tid] = racs; sDt[((c + 1) & 1) * 128 + tid] = rdt; }
      racs = nacs; rdt = ndt;
      LDS_BARRIER();
    }
    if (mode == 1 && wave >= 4) {
      float* sp = Sbuf + ((size_t)(seg * 128 + item) * 4 + (wave - 4)) * 1024 + lane * 16;
#pragma unroll
      for (int gi = 0; gi < 4; ++gi) { f32x4 v; v[0] = st[4 * gi]; v[1] = st[4 * gi + 1]; v[2] = st[4 * gi + 2]; v[3] = st[4 * gi + 3]; *(f32x4*)(sp + 4 * gi) = v; }
    }
    __syncthreads();
    if (tsum == 0x9e3779b9u && dry) sDt[0] = 1.f;
  }
}

DI void gnorm_phase(bf16_t* P, const float* nw, bool dry) {
  const int tid = otid(), lane = tid & 63, wave = tid >> 6;
  const int stride = gridDim.x * 8;
  for (int rg0 = blockIdx.x * 8 + wave; rg0 < T * 4; rg0 += stride * 4) {
    u32x4 r[4];
#pragma unroll
    for (int k = 0; k < 4; ++k) { const int rg = rg0 + k * stride; const int rgc = (rg < T * 4) ? rg : rg0; r[k] = *(const u32x4*)(P + (size_t)(rgc >> 2) * 5120 + (rgc & 3) * 512 + lane * 8); }
#pragma unroll
    for (int k = 0; k < 4; ++k) {
      const int rg = rg0 + k * stride;
      if (rg < T * 4) {
        const int t = rg >> 2, g = rg & 3;
        float f[8]; unpack8(r[k], f);
        float ss = 0.f;
#pragma unroll
        for (int e = 0; e < 8; ++e) ss += f[e] * f[e];
        ss = wave_sum(ss);
        const float rstd = rsqrtf(ss * (1.f / 512.f) + 1e-5f);
        const f32x4 w0 = *(const f32x4*)(nw + g * 512 + lane * 8), w1 = *(const f32x4*)(nw + g * 512 + lane * 8 + 4);
        f[0] *= rstd * w0[0]; f[1] *= rstd * w0[1]; f[2] *= rstd * w0[2]; f[3] *= rstd * w0[3];
        f[4] *= rstd * w1[0]; f[5] *= rstd * w1[1]; f[6] *= rstd * w1[2]; f[7] *= rstd * w1[3];
        if (!dry) *(u32x4*)(P + (size_t)t * 5120 + g * 512 + lane * 8) = pack8(f);
      }
    }
  }
}


#define XB_TMO      128
#define XB_XCNT(j)  (256  + 64 * (j))
#define XB_XSUB(j)  (1280 + 64 * (j))
#define XB_XGEN(j)  (2304 + 64 * (j))
#define XB_TOP      3328
#define XB_TOPGEN   3392
#define XCD_BAR_WORDS 3456
#define XB_SPIN_CAP (1u << 20)
#define LAS3 __attribute__((address_space(3)))
DI unsigned xb_ld(unsigned* p)              { return __hip_atomic_load(p, __ATOMIC_RELAXED, __HIP_MEMORY_SCOPE_AGENT); }
DI unsigned xb_add(unsigned* p, unsigned v) { return __hip_atomic_fetch_add(p, v, __ATOMIC_RELAXED, __HIP_MEMORY_SCOPE_AGENT); }
DI unsigned xb_xcc_id() { return (unsigned)__builtin_amdgcn_s_getreg((3 << 11) | 20) & 0xFu; }
#define XB_SPIN(cond, bar) do { unsigned _sp = 0; while (cond) { __builtin_amdgcn_s_sleep(1); \
    if ((++_sp & 255u) == 0u) { if (xb_ld(&(bar)[XB_TMO])) break; if (_sp > XB_SPIN_CAP) { atomicAdd(&(bar)[XB_TMO], 1u); break; } } } } while (0)
struct XcdBarrier { unsigned* bar; unsigned x; volatile LAS3 unsigned* st; };
DI XcdBarrier xcd_barrier_post(unsigned* bar, volatile LAS3 unsigned* st) {
  XcdBarrier b; b.bar = bar; b.x = xb_xcc_id(); b.st = st;
  if (threadIdx.x == 0) (void)xb_add(&bar[XB_XCNT(b.x)], 1u);
  return b;
}
DI void xcd_barrier_complete(unsigned* bar, unsigned x, unsigned& nloc, unsigned& nx) {
  const unsigned G = gridDim.x * gridDim.y * gridDim.z;
  unsigned sum, cnt, mine, sp = 0u;
  for (;;) {
    sum = 0u; cnt = 0u; mine = 0u;
#pragma unroll
    for (unsigned j = 0; j < 16; ++j) { const unsigned c = xb_ld(&bar[XB_XCNT(j)]); sum += c; cnt += (c > 0u) ? 1u : 0u; mine = (j == x) ? c : mine; }
    if (sum == G) break;
    __builtin_amdgcn_s_sleep(1);
    if ((++sp & 255u) == 0u) { if (xb_ld(&bar[XB_TMO])) break; if (sp > XB_SPIN_CAP) { atomicAdd(&bar[XB_TMO], 1u); break; } }
  }
  nloc = mine > 0u ? mine : 1u; nx = cnt > 0u ? cnt : 1u;
}
DI void xcd_barrier(const XcdBarrier& b) {
  asm volatile("s_waitcnt vmcnt(0)" ::: "memory");
  __syncthreads();
  if (threadIdx.x == 0) {
    unsigned* bar = b.bar;
    __builtin_amdgcn_s_waitcnt(0);
    unsigned nloc = b.st[0], nx = b.st[1];
    if (nloc == 0u) { xcd_barrier_complete(bar, b.x, nloc, nx); b.st[0] = nloc; b.st[1] = nx; }
    const unsigned old = xb_add(&bar[XB_XSUB(b.x)], 1u);
    const unsigned gen = old / nloc;
    if (old + 1u == (gen + 1u) * nloc) {
      __builtin_amdgcn_fence(__ATOMIC_RELEASE, "agent");
      asm volatile("s_waitcnt vmcnt(0)" ::: "memory");
      const unsigned og = xb_add(&bar[XB_TOP], 1u);
      const unsigned tg = og / nx;
      if (og + 1u == (tg + 1u) * nx) xb_add(&bar[XB_TOPGEN], 1u);
      else XB_SPIN(xb_ld(&bar[XB_TOPGEN]) == tg, bar);
      __builtin_amdgcn_fence(__ATOMIC_ACQUIRE, "agent");
      xb_add(&bar[XB_XGEN(b.x)], 1u);
      asm volatile("s_waitcnt vmcnt(0)" ::: "memory");
    } else {
      XB_SPIN(xb_ld(&bar[XB_XGEN(b.x)]) == gen, bar);
      __builtin_amdgcn_fence(__ATOMIC_ACQUIRE, "agent");
      asm volatile("s_waitcnt vmcnt(0)" ::: "memory");
    }
  }
  __syncthreads();
}

DI int phase_kind(int ph, int& L) {
  if (ph == NPH - 1) { L = 0; return 9; }
  if (ph == 0) { L = 0; return 0; }
  int sub;
  if (ph < 6) { L = 0; sub = ph; } else if (ph < 14) { L = 1; sub = ph - 5; } else if (ph < 19) { L = 2; sub = ph - 13; } else { L = 3; sub = ph - 18; }
  if (L & 1) { return (sub < 3) ? sub : (sub == 3) ? 10 : (sub < 7) ? sub - 1 : sub; }
  return (sub < 3) ? sub : ((sub == 3) ? 5 : sub + 3);
}
DI void run_phase(const Params& p, int ph, char* lds, bool dry) {
  int L;
  const int kind = phase_kind(ph, L);
  if (kind == 9) { final_norm_phase(p.S, p.final_norm_w, p.X); return; }
  const int i = L >> 1;
  const bool odd = L & 1;
  bf16_t* Wb = p.Wb;
  switch (kind) {
#if !defined(ONLY) || ((ONLY >> 0) & 1)
    case 0: {
      convert_mixer(p, 0, lds, 0);
      init_stream_phase(p.x, p.S, p.ssq);
    } break;
#endif
#if !defined(ONLY) || ((ONLY >> 1) & 1)
    case 1: {
      if (!odd) { pg8::EpiBf16 e{p.P, 1280, nullptr, nullptr, p.ssq}; gemm_run(p.S, 1024, Wb + W_IN, 1024, 1280, lds, e); }
      else { pg8::EpiBf16 e{p.P, 5120, p.dt, p.ssd_dt_bias + i * 32, p.ssq}; gemm_run(p.S, 1024, Wb + W_IN, 1024, 5376, lds, e); }
      convert_ffn(p, L, lds, idle_from(odd ? 64 * 21 : 64 * 5));
    } break;
#endif
#if !defined(ONLY) || ((ONLY >> 2) & 1)
    case 2: {
      if (!odd) {
        bf16_t* cat = p.P + (size_t)T * 1280;
        attn_phase(p.P, cat, p.ap_sinks + i * 8, lds);
        pool_phase(p.P, cat, Wb + W_POOL, p.pool_scale + i * 512, lds);
      } else {
        ssd_cb_phase(p.P, p.H, p.H + (size_t)512 * 16384, p.CB, p.dt, p.acs, p.ssd_conv_w + (size_t)i * 4 * 3072, p.ssd_conv_b + i * 3072, p.ssd_A_log + i * 32, lds);
      }
    } break;
#endif
#if !defined(ONLY) || ((ONLY >> 3) & 1)
    case 3: case 10: ssd_scan_phase(p.P, p.H, p.H + (size_t)512 * 16384, p.CB, p.dt, p.acs, p.ssd_conv_w + (size_t)i * 4 * 3072, p.ssd_conv_b + i * 3072, p.ssd_D + i * 32, lds, dry, kind == 10 ? 1 : 0, (float*)(p.bar + XCD_BAR_WORDS)); break;
#endif
#if !defined(ONLY) || ((ONLY >> 4) & 1)
    case 4: gnorm_phase(p.P, p.ssd_norm_w + i * 2048, dry); break;
#endif
#if !defined(ONLY) || ((ONLY >> 5) & 1)
    case 5: case 8: {
      pg8::EpiResid e{(kind == 5 && L == 0) ? p.x : nullptr, p.S, p.ssq, dry};
      const bf16_t* A; int lda, K; const bf16_t* Bt;
      if (kind == 8) { A = p.P; lda = 2816; K = 2816; Bt = Wb + W_DN; }
      else if (!odd) { A = p.P + (size_t)T * 1280; lda = 1024; K = 1024; Bt = Wb + W_OUT; }
      else { A = p.P; lda = 5120; K = 2048; Bt = Wb + W_OUT; }
      gemm_run(A, lda, Bt, K, 1024, lds, e);
    } break;
#endif
#if !defined(ONLY) || ((ONLY >> 7) & 1)
    case 7: { pg8::EpiSwiglu e{p.P, p.ssq}; gemm_run(p.S, 1024, Wb + W_GU, 1024, 5632, lds, e); if (L < 3) convert_mixer(p, L + 1, lds, idle_from(64 * 22)); } break;
#endif
    default: break;
  }
}

__global__ void __launch_bounds__(512) mega(Params p, int ph_lo, int ph_hi) {
  extern __shared__ __attribute__((aligned(16))) char lds[];
  volatile LAS3 unsigned* st = (volatile LAS3 unsigned*)(LAS3 char*)(lds + 144000);
  if (threadIdx.x < 4) st[threadIdx.x] = 0u;
  __syncthreads();
  XcdBarrier xb = xcd_barrier_post(p.bar, st);
  for (int ph = ph_lo; ph < ph_hi; ++ph) {
#ifdef DUPMASK
    { int L2; const int kind2 = phase_kind(ph, L2);
      if ((DUPMASK >> kind2) & 1) { run_phase(p, ph, lds, ph_lo == 0); xcd_barrier(xb); } }
#endif
    run_phase(p, ph, lds, false);
    if (ph + 1 < ph_hi) {
      if (ph_hi > 1000) cg::this_grid().sync();
      xcd_barrier(xb);
    }
  }
}

extern "C" void kernel_launch(void* const* d_in, const int* in_sizes, int n_in, void* d_out, int out_size, void* d_ws, size_t ws_size, hipStream_t stream) {
  Params p{};
  const float** f = (const float**)&p;
  for (int i = 0; i < 20; ++i) f[i] = (const float*)d_in[i];
  p.X = (float*)d_out;
  char* ws = (char*)d_ws;
  size_t off = 0;
  p.Wb = (bf16_t*)(ws + off); off += W_TOTAL * 2;
  p.H = (bf16_t*)(ws + off); off += (size_t)T * 1024 * 2;
  p.P = (bf16_t*)(ws + off); off += (size_t)T * 5120 * 2;
  p.S = (bf16_t*)(ws + off); off += (size_t)T * 1024 * 2;
  p.bar = (unsigned*)(ws + off); off += (size_t)XCD_BAR_WORDS * 4;
  off += (size_t)2 * 128 * 4 * 1024 * 4;
  { char* os = (char*)d_out; size_t oo = 0;
    p.CB = (bf16_t*)(os + oo); oo += (size_t)512 * 16384 * 2;
    p.dt = (float*)(os + oo); oo += (size_t)T * 32 * 4;
    p.acs = (float*)(os + oo); oo += (size_t)T * 32 * 4;
    p.ssq = (float*)(os + oo); oo += (size_t)T * 16 * 4; }
  static int grid = 0;
  if (!grid) {
    (void)hipFuncSetAttribute((const void*)mega, hipFuncAttributeMaxDynamicSharedMemorySize, (int)LDS_BYTES);
    int dev = 0, cus = 0, per_cu = 0;
    (void)hipGetDevice(&dev);
    (void)hipDeviceGetAttribute(&cus, hipDeviceAttributeMultiprocessorCount, dev);
    (void)hipOccupancyMaxActiveBlocksPerMultiprocessor(&per_cu, mega, 512, LDS_BYTES);
    if (per_cu < 1) per_cu = 1;
    grid = cus * per_cu;
    if (off > ws_size) fprintf(stderr, "workspace too small: need %zu have %zu\n", off, ws_size);
  }
  (void)hipMemsetAsync(p.bar, 0, (size_t)XCD_BAR_WORDS * 4, stream);
#if COOP
  int lo = 0, hi = NPH;
  void* args[] = {&p, &lo, &hi};
  hipError_t e = hipLaunchCooperativeKernel((void*)mega, dim3(grid), dim3(512), args, LDS_BYTES, stream);
  if (e != hipSuccess) fprintf(stderr, "cooperative launch failed: %s (grid %d)\n", hipGetErrorString(e), grid);
#else
  for (int ph = 0; ph < NPH; ++ph) hipLaunchKernelGGL(mega, dim3(grid), dim3(512), LDS_BYTES, stream, p, ph, ph + 1);
#endif
}
```
